# Optimizing an MI355X kernel written in HIP

```python
import math
import jax, jax.numpy as jnp
from jax import lax
import numpy as np

D_MODEL = 1024
BATCH = 2
SEQ = 16384
DEPTH = 1
DEC_BATCH = 16
DEC_SEQ = 16
PAST_LEN = 1024

CHUNK = 64
Q_BLOCK = 128
RMS_EPS = 1e-6
NEG_INF = -1e30
DELTA_HEADS = D_MODEL // 128
DELTA_DK = 128
DELTA_DV = 128
CONV_W = 4
DELTA_QKV_W = DELTA_HEADS * (2 * DELTA_DK + DELTA_DV)
DIFF_HEADS = D_MODEL // 128
DIFF_QK_DIM = 64
DIFF_V_DIM = 2 * DIFF_QK_DIM
IN_SPLIT_SIZES = (DELTA_QKV_W, DELTA_HEADS * DELTA_DV, DELTA_HEADS, DELTA_HEADS,
                  DIFF_HEADS * 2 * DIFF_QK_DIM, DIFF_HEADS * 2 * DIFF_QK_DIM, DIFF_HEADS * DIFF_V_DIM,
                  D_MODEL, D_MODEL)
IN_W = DELTA_QKV_W + DELTA_HEADS * DELTA_DV + 2 * DELTA_HEADS + DIFF_HEADS * (4 * DIFF_QK_DIM + DIFF_V_DIM) + 2 * D_MODEL
PEER_HEADS = 8
N_KEYS = 128
N_EXPERTS = N_KEYS * N_KEYS
PEER_DQ = 256
PEER_DHALF = PEER_DQ // 2
PEER_TOPK = 16
PEER_BLOCK = 256

kernel_name = 'hybrid_stream_gdn_diffattn_peer'


def rmsnorm(x, g):
    xf = x.astype(jnp.float32)
    y = xf * lax.rsqrt(jnp.mean(xf * xf, axis=-1, keepdims=True) + RMS_EPS) * g.astype(jnp.float32)
    return y.astype(x.dtype)


def l2norm(x):
    xf = x.astype(jnp.float32)
    return xf * lax.rsqrt(jnp.sum(xf * xf, axis=-1, keepdims=True) + RMS_EPS)


def gated_delta_rule(q, k, v, g, beta, s0):
    b, l, h, _ = q.shape
    dv = v.shape[-1]
    c = min(CHUNK, l)
    n = l // c
    f32 = jnp.float32

    def blocks(t):
        t = t.astype(f32).reshape((b, n, c, h) + t.shape[3:])
        return jnp.moveaxis(t, 3, 1)

    q, k, v, g, beta = (blocks(t) for t in (q, k, v, g, beta))
    gcum = jnp.cumsum(g, axis=-1)
    incl = jnp.tril(jnp.ones((c, c), bool))
    strict = jnp.tril(jnp.ones((c, c), bool), -1)
    diff = gcum[..., :, None] - gcum[..., None, :]
    decay = jnp.where(incl, jnp.exp(jnp.where(incl, diff, 0.0)), 0.0)
    kb = k * beta[..., None]
    vb = v * beta[..., None]
    lmat = jnp.where(strict, jnp.einsum('bhnid,bhnjd->bhnij', kb, k) * decay, 0.0)
    eye = jnp.eye(c, dtype=f32)
    tmat = lax.linalg.triangular_solve(lmat + eye, jnp.broadcast_to(eye, lmat.shape),
                                       left_side=True, lower=True, unit_diagonal=True)
    w = jnp.einsum('bhnij,bhnjd->bhnid', tmat, kb * jnp.exp(gcum)[..., None])
    u = jnp.einsum('bhnij,bhnjd->bhnid', tmat, vb)
    intra = jnp.einsum('bhnid,bhnjd->bhnij', q, k) * decay
    qg = q * jnp.exp(gcum)[..., None]
    glast = gcum[..., -1]
    kd = k * jnp.exp(glast[..., None] - gcum)[..., None]

    def step(s, xs):
        w_n, u_n, qg_n, intra_n, kd_n, gl_n = xs
        v_new = u_n - jnp.einsum('bhcd,bhde->bhce', w_n, s)
        o_n = jnp.einsum('bhcd,bhde->bhce', qg_n, s) + jnp.einsum('bhij,bhje->bhie', intra_n, v_new)
        s = s * jnp.exp(gl_n)[..., None, None] + jnp.einsum('bhcd,bhce->bhde', kd_n, v_new)
        return s, o_n

    xs = tuple(jnp.moveaxis(t, 2, 0) for t in (w, u, qg, intra, kd, glast))
    s_fin, o = lax.scan(step, s0.astype(f32), xs)
    o = jnp.transpose(o, (1, 0, 3, 2, 4)).reshape(b, l, h, dv)
    return o, s_fin


def diff_softmax_mix(q, k, v, lam, mask):
    s = jnp.einsum('bqhmd,bkhmd->bhmqk', q, k).astype(jnp.float32) * (DIFF_QK_DIM ** -0.5)
    if mask is not None:
        s = jnp.where(mask, s, NEG_INF)
    p = jax.nn.softmax(s, axis=-1)
    wgt = p[:, :, 0] - lam * p[:, :, 1]
    return jnp.einsum('bhqk,bkhd->bqhd', wgt.astype(v.dtype), v)


def diff_attn_prompt(q, k, v, lam):
    b, l = q.shape[:2]
    nb = l // Q_BLOCK
    qb = jnp.moveaxis(q.reshape((b, nb, Q_BLOCK) + q.shape[2:]), 1, 0)
    key_chunk = jnp.arange(l) // CHUNK

    def one(args):
        i, qi = args
        q_chunk = (i * Q_BLOCK + jnp.arange(Q_BLOCK)) // CHUNK
        mask = key_chunk[None, :] <= q_chunk[:, None]
        return diff_softmax_mix(qi, k, v, lam, mask)

    out = lax.map(one, (jnp.arange(nb), qb))
    return jnp.moveaxis(out, 0, 1).reshape(b, l, DIFF_HEADS, DIFF_V_DIM)


def peer(xn, w_q, sub_keys, u_tab, v_tab):
    b, l, d = xn.shape
    t = b * l
    nblk = -(-t // PEER_BLOCK)
    xt = jnp.pad(xn.reshape(t, d), ((0, nblk * PEER_BLOCK - t), (0, 0))).reshape(nblk, PEER_BLOCK, d)

    def one(xb):
        qh = (xb @ w_q).reshape(PEER_BLOCK, PEER_HEADS, 2, PEER_DHALF)
        s = jnp.einsum('thpd,hpnd->thpn', qh, sub_keys).astype(jnp.float32)
        sv, si = lax.top_k(s, PEER_TOPK)
        cand = (sv[:, :, 0, :, None] + sv[:, :, 1, None, :]).reshape(PEER_BLOCK, PEER_HEADS, PEER_TOPK * PEER_TOPK)
        cid = (si[:, :, 0, :, None] * N_KEYS + si[:, :, 1, None, :]).reshape(PEER_BLOCK, PEER_HEADS, PEER_TOPK * PEER_TOPK)
        top_v, top_pos = lax.top_k(cand, PEER_TOPK)
        eid = jnp.take_along_axis(cid, top_pos, axis=-1)
        gate = jax.nn.softmax(top_v, axis=-1)
        ue = u_tab[eid]
        ve = v_tab[eid]
        act = jax.nn.gelu(jnp.einsum('td,thkd->thk', xb, ue).astype(jnp.float32), approximate=False)
        return jnp.einsum('thk,thkd->td', (gate * act).astype(ve.dtype), ve)

    out = lax.map(one, xt).reshape(nblk * PEER_BLOCK, d)[:t]
    return out.reshape(b, l, d)


def layer(x, conv_buf, s0, past_k, past_v, lam_init, p):
    (norm_mix_g, w_in, conv_w, a_log, dt_bias, delta_norm_g, q_norm_g, k_norm_g,
     lq1, lk1, lq2, lk2, diff_norm_g, w_out, norm_ffn_g, peer_w_q, peer_sub_keys, peer_u, peer_v) = p
    b, l, _ = x.shape
    xn = rmsnorm(x, norm_mix_g)
    proj = xn @ w_in
    splits, acc = [], 0
    for sz in IN_SPLIT_SIZES[:-1]:
        acc += sz
        splits.append(acc)
    qkv, z, beta_raw, a_raw, fq, fk, fv, gate_a, gate_b = jnp.split(proj, splits, axis=-1)

    ext = jnp.concatenate([conv_buf.astype(qkv.dtype), qkv], axis=1)
    new_conv = ext[:, -(CONV_W - 1):]
    conv = conv_w[0] * ext[:, 0:l]
    for j in range(1, CONV_W):
        conv = conv + conv_w[j] * ext[:, j:j + l]
    qkv_c = jax.nn.silu(conv)
    dq, dk, dv = jnp.split(qkv_c, [DELTA_HEADS * DELTA_DK, 2 * DELTA_HEADS * DELTA_DK], axis=-1)
    dq = l2norm(dq.reshape(b, l, DELTA_HEADS, DELTA_DK)) * (DELTA_DK ** -0.5)
    dk = l2norm(dk.reshape(b, l, DELTA_HEADS, DELTA_DK))
    dv = dv.reshape(b, l, DELTA_HEADS, DELTA_DV)
    beta = jax.nn.sigmoid(beta_raw.astype(jnp.float32))
    g = -jnp.exp(a_log.astype(jnp.float32)) * jax.nn.softplus(a_raw.astype(jnp.float32) + dt_bias.astype(jnp.float32))
    o_a, s_new = gated_delta_rule(dq, dk, dv, g, beta, s0)
    o_a = rmsnorm(o_a, delta_norm_g) * jax.nn.silu(z.reshape(b, l, DELTA_HEADS, DELTA_DV).astype(jnp.float32))
    o_a = o_a.reshape(b, l, DELTA_HEADS * DELTA_DV).astype(x.dtype)

    fq = rmsnorm(fq.reshape(b, l, DIFF_HEADS, 2, DIFF_QK_DIM), q_norm_g)
    fk = rmsnorm(fk.reshape(b, l, DIFF_HEADS, 2, DIFF_QK_DIM), k_norm_g)
    fv = fv.reshape(b, l, DIFF_HEADS, DIFF_V_DIM)
    lam = (jnp.exp(jnp.sum(lq1.astype(jnp.float32) * lk1.astype(jnp.float32)))
           - jnp.exp(jnp.sum(lq2.astype(jnp.float32) * lk2.astype(jnp.float32))) + lam_init)
    if past_k is None:
        o_b = diff_attn_prompt(fq, fk, fv, lam)
    else:
        keys = jnp.concatenate([past_k.astype(fk.dtype), fk], axis=1)
        vals = jnp.concatenate([past_v.astype(fv.dtype), fv], axis=1)
        o_b = diff_softmax_mix(fq, keys, vals, lam, None)
    o_b = (rmsnorm(o_b, diff_norm_g) * (1.0 - lam_init)).reshape(b, l, DIFF_HEADS * DIFF_V_DIM)

    merged = jax.nn.sigmoid(gate_a) * o_a + jax.nn.sigmoid(gate_b) * o_b
    h = x + (merged @ w_out).astype(x.dtype)
    y = h + peer(rmsnorm(h, norm_ffn_g), peer_w_q, peer_sub_keys, peer_u, peer_v).astype(x.dtype)
    return y, fk, fv, s_new, new_conv


def setup_inputs(seed: int = 0) -> dict:
    key = jax.random.key(seed)
    ks = jax.random.split(key, 32)
    f32 = jnp.float32

    def nrm(k, shape, scale):
        return scale * jax.random.normal(k, shape, f32)

    def gain(k, n):
        return 1.0 + 0.02 * jax.random.normal(k, (DEPTH, n), f32)

    dt = jnp.exp(jax.random.uniform(ks[8], (DEPTH, DELTA_HEADS), f32, math.log(1e-3), math.log(1e-1)))
    return {
        'x_prompt': nrm(ks[0], (BATCH, SEQ, D_MODEL), 1.0),
        'x_sample': nrm(ks[1], (DEC_BATCH, DEC_SEQ, D_MODEL), 1.0),
        'cache_diff_k': nrm(ks[2], (DEPTH, DEC_BATCH, PAST_LEN, DIFF_HEADS, 2, DIFF_QK_DIM), 1.0),
        'cache_diff_v': nrm(ks[3], (DEPTH, DEC_BATCH, PAST_LEN, DIFF_HEADS, DIFF_V_DIM), 1.0),
        'state_delta_s': nrm(ks[4], (DEPTH, DEC_BATCH, DELTA_HEADS, DELTA_DK, DELTA_DV), 0.1),
        'state_delta_conv': nrm(ks[5], (DEPTH, DEC_BATCH, CONV_W - 1, DELTA_QKV_W), 1.0),
        'norm_mix_g': gain(ks[6], D_MODEL),
        'w_in': nrm(ks[7], (DEPTH, D_MODEL, IN_W), D_MODEL ** -0.5),
        'conv_w': nrm(ks[9], (DEPTH, CONV_W, DELTA_QKV_W), CONV_W ** -0.5),
        'delta_a_log': jnp.log(jax.random.uniform(ks[10], (DEPTH, DELTA_HEADS), f32, 1.0, 16.0)),
        'delta_dt_bias': dt + jnp.log(-jnp.expm1(-dt)),
        'delta_norm_g': gain(ks[11], DELTA_DV),
        'diff_q_norm_g': gain(ks[12], DIFF_QK_DIM),
        'diff_k_norm_g': gain(ks[13], DIFF_QK_DIM),
        'diff_lambda_q1': nrm(ks[14], (DEPTH, DIFF_QK_DIM), 0.1),
        'diff_lambda_k1': nrm(ks[15], (DEPTH, DIFF_QK_DIM), 0.1),
        'diff_lambda_q2': nrm(ks[16], (DEPTH, DIFF_QK_DIM), 0.1),
        'diff_lambda_k2': nrm(ks[17], (DEPTH, DIFF_QK_DIM), 0.1),
        'diff_norm_g': gain(ks[18], DIFF_V_DIM),
        'w_out': nrm(ks[19], (DEPTH, D_MODEL, D_MODEL), D_MODEL ** -0.5),
        'norm_ffn_g': gain(ks[20], D_MODEL),
        'peer_w_q': nrm(ks[21], (DEPTH, D_MODEL, PEER_HEADS * PEER_DQ), D_MODEL ** -0.5),
        'peer_sub_keys': nrm(ks[22], (DEPTH, PEER_HEADS, 2, N_KEYS, PEER_DHALF), PEER_DHALF ** -0.5),
        'peer_u': nrm(ks[23], (DEPTH, N_EXPERTS, D_MODEL), D_MODEL ** -0.5),
        'peer_v': nrm(ks[24], (DEPTH, N_EXPERTS, D_MODEL), D_MODEL ** -0.5),
    }


def reference(x_prompt, x_sample, cache_diff_k, cache_diff_v, state_delta_s, state_delta_conv,
              norm_mix_g, w_in, conv_w, delta_a_log, delta_dt_bias, delta_norm_g,
              diff_q_norm_g, diff_k_norm_g, diff_lambda_q1, diff_lambda_k1, diff_lambda_q2, diff_lambda_k2,
              diff_norm_g, w_out, norm_ffn_g, peer_w_q, peer_sub_keys, peer_u, peer_v):
    yp, ys = x_prompt, x_sample
    kp, vp, sp, cp = [], [], [], []
    kq, vq, sq, cq = [], [], [], []
    for l in range(DEPTH):
        p = (norm_mix_g[l], w_in[l], conv_w[l], delta_a_log[l], delta_dt_bias[l], delta_norm_g[l],
             diff_q_norm_g[l], diff_k_norm_g[l], diff_lambda_q1[l], diff_lambda_k1[l],
             diff_lambda_q2[l], diff_lambda_k2[l], diff_norm_g[l], w_out[l], norm_ffn_g[l],
             peer_w_q[l], peer_sub_keys[l], peer_u[l], peer_v[l])
        lam_init = 0.8 - 0.6 * math.exp(-0.3 * l)
        conv0 = jnp.zeros((yp.shape[0], CONV_W - 1, DELTA_QKV_W), yp.dtype)
        s0 = jnp.zeros((yp.shape[0], DELTA_HEADS, DELTA_DK, DELTA_DV), jnp.float32)
        yp, k_new, v_new, s_new, c_new = layer(yp, conv0, s0, None, None, lam_init, p)
        kp.append(k_new); vp.append(v_new); sp.append(s_new); cp.append(c_new)
        ys, k_new, v_new, s_new, c_new = layer(ys, state_delta_conv[l], state_delta_s[l],
                                               cache_diff_k[l], cache_diff_v[l], lam_init, p)
        kq.append(k_new); vq.append(v_new); sq.append(s_new); cq.append(c_new)
    return (yp, ys,
            jnp.stack(kp), jnp.stack(vp), jnp.stack(sp), jnp.stack(cp),
            jnp.stack(kq), jnp.stack(vq), jnp.stack(sq), jnp.stack(cq))
```

```cpp
#include <hip/hip_runtime.h>
#include <hip/hip_cooperative_groups.h>
#include <stdint.h>
#include <stdio.h>
namespace cg = cooperative_groups;

#define NT 512
#define ONE_LAUNCH 1
#define DI __device__ __forceinline__
typedef unsigned short u16;
typedef unsigned int u32;
using bf16x8 = __attribute__((ext_vector_type(8))) short;
using f32x4 = __attribute__((ext_vector_type(4))) float;
using f32x16 = __attribute__((ext_vector_type(16))) float;
using u32x4 = __attribute__((ext_vector_type(4))) unsigned;
using u32x2 = __attribute__((ext_vector_type(2))) unsigned;

constexpr int D = 1024, TP = 32768, TS = 256, TT = 33024, SEQ = 16384, INW = 9232;
constexpr int C_Z = 3072, C_BETA = 4096, C_FQ = 4112, C_GA = 7184, C_GB = 8208;
constexpr size_t O_KP = 33816576, O_VP = 67371008, O_SP = 100925440, O_CP = 101187584, O_KS = 101206016,
                 O_VS = 101468160, O_SS = 101730304, O_CS = 103827456;
constexpr size_t WS_WIN = 0, WS_WOUT = 18907136, WS_WQ = 21004288, WS_SK = 25198592, WS_U = 25722880, WS_V = 59277312,
                 WS_BIG = 92831744, WS_OA = 295731200, WS_OB = 363364352, WS_BETA = 430997504, WS_G = 432054272,
                 WS_SSQ = 433111040, WS_SEL = 441565184, WS_GL = 475381760, WS_END = 475398144;
constexpr size_t BIG_KN = 67633152, BIG_VT = 135266304;
constexpr int LDS_BYTES = 163840;
constexpr float RMS_EPS = 1e-6f;
constexpr float LOG2E = 1.4426950408889634f;
constexpr float QSCALE = LOG2E * 0.125f;
constexpr float LAM_INIT = 0.2f;

struct P {
  const float *x_prompt, *x_sample, *cache_k, *cache_v, *state_s, *state_conv, *norm_mix_g, *w_in, *conv_w, *a_log,
      *dt_bias, *delta_norm_g, *qn_g, *kn_g, *lq1, *lk1, *lq2, *lk2, *diff_norm_g, *w_out, *norm_ffn_g, *peer_wq,
      *peer_sk, *peer_u, *peer_v;
  float* out;
  char* ws;
};

typedef float f32x2 __attribute__((ext_vector_type(2)));
typedef __bf16 bfx2 __attribute__((ext_vector_type(2)));
DI u32 pack2(float a, float b) { f32x2 v = {a, b}; bfx2 r = __builtin_convertvector(v, bfx2); return __builtin_bit_cast(u32, r); }
DI u16 f2bf(float x) { return (u16)(pack2(x, x) & 0xffffu); }
DI float bf2f(u16 b) { return __uint_as_float(((u32)b) << 16); }
DI float bflo(u32 w) { return __uint_as_float(w << 16); }
DI float bfhi(u32 w) { return __uint_as_float(w & 0xffff0000u); }
DI float wave_sum(float v) { for (int m = 32; m >= 1; m >>= 1) v += __shfl_xor(v, m); return v; }
DI float wave_max(float v) { for (int m = 32; m >= 1; m >>= 1) v = fmaxf(v, __shfl_xor(v, m)); return v; }
#define DPP_ADD(v, ctrl) ((v) + __int_as_float(__builtin_amdgcn_update_dpp(0, __float_as_int(v), (ctrl), 0xF, 0xF, true)))
DI float row16_sum(float v) { v = DPP_ADD(v, 0xB1); v = DPP_ADD(v, 0x4E); v = DPP_ADD(v, 0x124); v = DPP_ADD(v, 0x128); return v; }
DI float sigmoidf_(float x) { return 1.f / (1.f + __expf(-x)); }
DI f32x4 mfma16(bf16x8 a, bf16x8 b, f32x4 c) { return __builtin_amdgcn_mfma_f32_16x16x32_bf16(a, b, c, 0, 0, 0); }
DI f32x16 mfma32(bf16x8 a, bf16x8 b, f32x16 c) { return __builtin_amdgcn_mfma_f32_32x32x16_bf16(a, b, c, 0, 0, 0); }
DI bf16x8 ldfrag(const u16* p) { return *(const bf16x8*)p; }
#define VPERM(a) ((((a) & 1) << 1) | ((a) >> 1))

#define RAW_BARRIER() do { asm volatile("s_waitcnt lgkmcnt(0)" ::: "memory"); __builtin_amdgcn_s_barrier(); } while (0)
template <int N> DI void wait_vmcnt() { asm volatile("s_waitcnt vmcnt(%0)" ::"n"(N) : "memory"); }

template <int BN, bool MERGE, bool SWAP, int NJ, class BRow, int TM = 4>
DI void gemm_main(const u16* __restrict__ A, int m0, BRow brow, char* smem, f32x4 (&acc)[TM][NJ]) {
  constexpr int BM = TM * 64;
  constexpr int NIA = BM / 64, NIB = BN / 64;
  constexpr int NI = NIA + NIB;
  constexpr int STAGE = (BM + BN) * 128;
  constexpr int NST = (3 * STAGE <= LDS_BYTES) ? 3 : 2;
  const int tid = threadIdx.x, lane = tid & 63, w = __builtin_amdgcn_readfirstlane(tid >> 6), wm = w >> 1, wn = w & 1;
#pragma unroll
  for (int i = 0; i < TM; i++)
#pragma unroll
    for (int j = 0; j < NJ; j++) acc[i][j] = f32x4{0.f, 0.f, 0.f, 0.f};
  const u16* ga[NIA];
  const u16* gb[NIB];
#pragma unroll
  for (int ii = 0; ii < NIA; ii++) {
    int r = (w * NIA + ii) * 8 + (lane >> 3), c = (lane & 7) ^ ((r >> 1) & 7);
    ga[ii] = A + (size_t)(m0 + r) * 1024 + c * 8;
  }
#pragma unroll
  for (int ii = 0; ii < NIB; ii++) {
    int r = (w * NIB + ii) * 8 + (lane >> 3), c = (lane & 7) ^ ((r >> 1) & 7);
    gb[ii] = brow(r) + c * 8;
  }
  auto glds = [&](int kt, int st) {
    char* da = smem + st * STAGE + w * (NIA * 1024);
    char* db = smem + st * STAGE + BM * 128 + w * (NIB * 1024);
#pragma unroll
    for (int ii = 0; ii < NIA; ii++) __builtin_amdgcn_global_load_lds((const unsigned*)(ga[ii] + kt * 64), (unsigned*)(da + ii * 1024), 16, 0, 0);
#pragma unroll
    for (int ii = 0; ii < NIB; ii++) __builtin_amdgcn_global_load_lds((const unsigned*)(gb[ii] + kt * 64), (unsigned*)(db + ii * 1024), 16, 0, 0);
  };
  const int l15 = lane & 15, l4 = lane >> 4;
  const int swz = (l15 >> 1) & 7;
  __syncthreads();
  wait_vmcnt<0>();
  glds(0, 0);
  if (NST == 3) glds(1, 1);
  for (int kt = 0; kt < 16; kt++) {
    if (NST == 3) { if (kt + 1 < 16) wait_vmcnt<NI>(); else wait_vmcnt<0>(); }
    else wait_vmcnt<0>();
    RAW_BARRIER();
    if (NST == 3) { if (kt + 2 < 16) glds(kt + 2, (kt + 2) % 3); }
    else { if (kt + 1 < 16) glds(kt + 1, (kt + 1) & 1); }
    const char* As = smem + (NST == 3 ? kt % 3 : kt & 1) * STAGE;
    const char* Bs = As + BM * 128;
    bf16x8 af[2][TM], bfr[2][NJ];
#pragma unroll
    for (int kk = 0; kk < 2; kk++) {
      const int coff = ((kk * 4 + l4) ^ swz) << 4;
#pragma unroll
      for (int i = 0; i < TM; i++) af[kk][i] = *(const bf16x8*)(As + (wm * (TM * 16) + i * 16 + l15) * 128 + coff);
#pragma unroll
      for (int j = 0; j < NJ; j++) {
        int nrow = MERGE ? ((j >> 1) * 64 + wn * 32 + (j & 1) * 16) : (wn * 64 + j * 16);
        bfr[kk][j] = *(const bf16x8*)(Bs + (nrow + l15) * 128 + coff);
      }
      __builtin_amdgcn_sched_barrier(0);
    }
#pragma unroll
    for (int kk = 0; kk < 2; kk++) {
#pragma unroll
      for (int i = 0; i < TM; i++)
#pragma unroll
        for (int j = 0; j < NJ; j++) acc[i][j] = SWAP ? mfma16(bfr[kk][j], af[kk][i], acc[i][j]) : mfma16(af[kk][i], bfr[kk][j], acc[i][j]);
      __builtin_amdgcn_sched_barrier(0);
    }
  }
  __syncthreads();
}

DI void transpose_unit(const float* __restrict__ W, int N, u16* __restrict__ WT, int unit, int lane) {
  int nblk = unit >> 3, kblk = unit & 7;
  int n = nblk * 64 + lane, k0 = kblk * 128;
  if (n < N) {
    for (int kk = 0; kk < 128; kk += 8) {
      float v[8];
#pragma unroll
      for (int i = 0; i < 8; i++) v[i] = W[(size_t)(k0 + kk + i) * N + n];
      u32x4 o = {pack2(v[0], v[1]), pack2(v[2], v[3]), pack2(v[4], v[5]), pack2(v[6], v[7])};
      *(u32x4*)(WT + (size_t)n * 1024 + k0 + kk) = o;
    }
  }
}

DI void conv_tab(const float* __restrict__ src, u16* __restrict__ dst, size_t n4, size_t gtid, size_t gstride) {
  for (size_t i = gtid; i < n4; i += gstride) {
    float4 v = ((const float4*)src)[i];
    u32x2 o = {pack2(v.x, v.y), pack2(v.z, v.w)};
    ((u32x2*)dst)[i] = o;
  }
}

DI void phase0(const P& p, char* smem, int bid, int nb) {
  const int tid = threadIdx.x, lane = tid & 63, w = tid >> 6;
  u16* XN = (u16*)p.out;
  float* BETA = (float*)(p.ws + WS_BETA);
  float* G = (float*)(p.ws + WS_G);
  float* Wt = (float*)smem;
  for (int i = tid; i < 4096; i += NT) {
    int k = i >> 2, q = i & 3;
    float4 wv = *(const float4*)(p.w_in + (size_t)k * INW + C_BETA + q * 4);
    Wt[(q * 4 + 0) * 1024 + k] = wv.x; Wt[(q * 4 + 1) * 1024 + k] = wv.y; Wt[(q * 4 + 2) * 1024 + k] = wv.z; Wt[(q * 4 + 3) * 1024 + k] = wv.w;
  }
  __syncthreads();
#pragma unroll 2
  for (int row = bid * 8 + w; row < TT; row += nb * 8) {
    const float* xr = row < TP ? p.x_prompt + (size_t)row * D : p.x_sample + (size_t)(row - TP) * D;
    float xn[16];
    float ss = 0.f;
#pragma unroll
    for (int i = 0; i < 4; i++) {
      float4 v = *(const float4*)(xr + i * 256 + lane * 4);
      xn[4 * i] = v.x; xn[4 * i + 1] = v.y; xn[4 * i + 2] = v.z; xn[4 * i + 3] = v.w;
      ss += v.x * v.x + v.y * v.y + v.z * v.z + v.w * v.w;
    }
    ss = wave_sum(ss);
    float rinv = rsqrtf(ss * (1.f / 1024.f) + RMS_EPS);
#pragma unroll
    for (int i = 0; i < 4; i++) {
      float4 g4 = *(const float4*)(p.norm_mix_g + i * 256 + lane * 4);
      xn[4 * i] *= rinv * g4.x; xn[4 * i + 1] *= rinv * g4.y; xn[4 * i + 2] *= rinv * g4.z; xn[4 * i + 3] *= rinv * g4.w;
      u32x2 o = {pack2(xn[4 * i], xn[4 * i + 1]), pack2(xn[4 * i + 2], xn[4 * i + 3])};
      *(u32x2*)(XN + (size_t)row * 1024 + i * 256 + lane * 4) = o;
    }
    float v = 0.f;
#pragma nounroll
    for (int jg = 0; jg < 4; jg++) {
      float d4[4] = {0.f, 0.f, 0.f, 0.f};
#pragma unroll
      for (int q = 0; q < 4; q++)
#pragma unroll
        for (int i = 0; i < 4; i++) {
          float4 wv = *(const float4*)(Wt + (jg * 4 + q) * 1024 + i * 256 + lane * 4);
          d4[q] += xn[4 * i] * wv.x + xn[4 * i + 1] * wv.y + xn[4 * i + 2] * wv.z + xn[4 * i + 3] * wv.w;
        }
#pragma unroll
      for (int q = 0; q < 4; q++) { float r = wave_sum(d4[q]); v = (lane == jg * 4 + q) ? r : v; }
    }
    if (lane < 8) BETA[row * 8 + lane] = sigmoidf_(v);
    else if (lane < 16) {
      int hh = lane - 8;
      float xx = v + p.dt_bias[hh];
      float sp = xx > 20.f ? xx : log1pf(expf(xx));
      G[row * 8 + hh] = -expf(p.a_log[hh]) * sp;
    }
  }
  {
    const int gw = bid * 8 + w, gws = nb * 8;
    for (int u = gw; u < 145 * 8; u += gws) transpose_unit(p.w_in, INW, (u16*)(p.ws + WS_WIN), u, lane);
  }
}

template <int TM>
DI void phase1_tile(const P& p, char* smem, int m0, int n0) {
  const u16* XN = (const u16*)p.out;
  const u16* WT = (const u16*)(p.ws + WS_WIN);
  u16* QKV = (u16*)(p.ws + WS_BIG);
  const int lane = threadIdx.x & 63, w = __builtin_amdgcn_readfirstlane(threadIdx.x >> 6), wm = w >> 1, wn = w & 1;
  f32x4 acc[TM][4];
  auto brow = [&](int r) { return WT + (size_t)(n0 + r) * 1024; };
  gemm_main<128, false, true, 4, decltype(brow), TM>(XN, m0, brow, smem, acc);
#pragma unroll
  for (int i = 0; i < TM; i++) {
    int tok = m0 + wm * (TM * 16) + i * 16 + (lane & 15);
    float* cdst = nullptr;
    if (tok < TP) { int b = tok >> 14, tt = tok & 16383; if (tt >= 16381) cdst = p.out + O_CP + (size_t)(b * 3 + tt - 16381) * 3072; }
    else { int s = (tok - TP) >> 4, tt = tok & 15; if (tt >= 13) cdst = p.out + O_CS + (size_t)(s * 3 + tt - 13) * 3072; }
#pragma unroll
    for (int j = 0; j < 4; j++) {
      int n = n0 + wn * 64 + j * 16 + 4 * (lane >> 4);
      f32x4 a = acc[i][j];
      u32x2 o = {pack2(a[0], a[1]), pack2(a[2], a[3])};
      *(u32x2*)(QKV + (size_t)tok * 3072 + n) = o;
      if (cdst) *(float4*)(cdst + n) = make_float4(a[0], a[1], a[2], a[3]);
    }
  }
}
DI void phase1(const P& p, char* smem, int bid, int nb) {
  for (int t = bid; t < 128 * 24; t += nb) phase1_tile<4>(p, smem, (t / 24) * 256, (t % 24) * 128);
  for (int t = bid; t < 4 * 24; t += nb) phase1_tile<1>(p, smem, TP + (t / 24) * 64, (t % 24) * 128);
}

DI void phase2(const P& p, char* smem, int bid, int nb) {
  const int tid = threadIdx.x, lane = tid & 63, w = __builtin_amdgcn_readfirstlane(tid >> 6);
  const u16* QKV = (const u16*)(p.ws + WS_BIG);
  const float* BETA = (const float*)(p.ws + WS_BETA);
  const float* G = (const float*)(p.ws + WS_G);
  float* GL = (float*)(p.ws + WS_GL);
  u16* NEGWU = (u16*)(p.out + O_KP);
  u16* KDQG = (u16*)(p.out + O_VP);
  u16* INTRA = (u16*)((char*)p.out + 67633152);
  u16* Kb = (u16*)smem;
  u16* Qb = Kb + 64 * 136;
  float* Lf = (float*)(Qb + 64 * 136);
  float* Tf = Lf + 64 * 65;
  u16* Tb = (u16*)(Tf + 64 * 65);
  u16* KBGt = Tb + 64 * 72;
  u16* VBt = KBGt + 128 * 72;
  float* Ys = (float*)(VBt + 128 * 72);
  float* gc = Ys + 16 * 17;
  float* bt = gc + 64;

  for (int item = bid; item < 4096; item += nb) {
    const int h = item & 7, n = (item >> 3) & 255, b = item >> 11;
    const int tok0 = b * SEQ + n * 64;
    const int sidx = (b * 8 + h) * 256 + n;
    const int r = tid >> 3, seg = tid & 7;
    __syncthreads();
    if (tid < 64) {
      float g = G[(tok0 + tid) * 8 + h];
      for (int off = 1; off < 64; off <<= 1) { float o = __shfl_up(g, off); if (lane >= off) g += o; }
      gc[tid] = g;
      bt[tid] = BETA[(tok0 + tid) * 8 + h];
      if (tid == 63) GL[(b * 8 + h) * 256 + n] = __expf(g);
    }
    float qv[16], kv[16], vv[16];
#pragma unroll
    for (int mat = 0; mat < 3; mat++) {
      float val[16];
#pragma unroll
      for (int c = 0; c < 16; c++) val[c] = 0.f;
      const int col = mat * 1024 + h * 128 + seg * 16;
#pragma unroll
      for (int j = 0; j < 4; j++) {
        int tl = n * 64 + r - 3 + j;
        if (tl >= 0) {
          const u16* src = QKV + (size_t)(tok0 + r - 3 + j) * 3072 + col;
          u32x4 r0 = *(const u32x4*)src, r1 = *(const u32x4*)(src + 8);
          const float4* cw = (const float4*)(p.conv_w + j * 3072 + col);
          float4 c0 = cw[0], c1 = cw[1], c2 = cw[2], c3 = cw[3];
          val[0] += c0.x * bflo(r0[0]); val[1] += c0.y * bfhi(r0[0]); val[2] += c0.z * bflo(r0[1]); val[3] += c0.w * bfhi(r0[1]);
          val[4] += c1.x * bflo(r0[2]); val[5] += c1.y * bfhi(r0[2]); val[6] += c1.z * bflo(r0[3]); val[7] += c1.w * bfhi(r0[3]);
          val[8] += c2.x * bflo(r1[0]); val[9] += c2.y * bfhi(r1[0]); val[10] += c2.z * bflo(r1[1]); val[11] += c2.w * bfhi(r1[1]);
          val[12] += c3.x * bflo(r1[2]); val[13] += c3.y * bfhi(r1[2]); val[14] += c3.z * bflo(r1[3]); val[15] += c3.w * bfhi(r1[3]);
        }
      }
      float ss = 0.f;
#pragma unroll
      for (int c = 0; c < 16; c++) { float x = val[c]; x = x / (1.f + __expf(-x)); val[c] = x; ss += x * x; }
      if (mat < 2) {
        ss += __shfl_xor(ss, 1); ss += __shfl_xor(ss, 2); ss += __shfl_xor(ss, 4);
        float rinv = rsqrtf(ss + RMS_EPS) * (mat == 0 ? 0.08838834764831845f : 1.f);
#pragma unroll
        for (int c = 0; c < 16; c++) val[c] *= rinv;
      }
#pragma unroll
      for (int c = 0; c < 16; c++) { if (mat == 0) qv[c] = val[c]; else if (mat == 1) kv[c] = val[c]; else vv[c] = val[c]; }
    }
    __syncthreads();
    const float gr = gc[r], br = bt[r], glast = gc[63];
    const float eg = __expf(gr), ekd = __expf(glast - gr);
    u16* qg_out = KDQG + (size_t)sidx * 16384 + 8192;
    u16* kdT_out = KDQG + (size_t)sidx * 16384;
    {
      u32x4 o0, o1, k0, k1, q0, q1;
#pragma unroll
      for (int c = 0; c < 4; c++) {
        o0[c] = pack2(qv[2 * c] * eg, qv[2 * c + 1] * eg); o1[c] = pack2(qv[8 + 2 * c] * eg, qv[9 + 2 * c] * eg);
        k0[c] = pack2(kv[2 * c], kv[2 * c + 1]); k1[c] = pack2(kv[8 + 2 * c], kv[9 + 2 * c]);
        q0[c] = pack2(qv[2 * c], qv[2 * c + 1]); q1[c] = pack2(qv[8 + 2 * c], qv[9 + 2 * c]);
      }
      *(u32x4*)(qg_out + r * 128 + seg * 16) = o0; *(u32x4*)(qg_out + r * 128 + seg * 16 + 8) = o1;
      *(u32x4*)(Kb + r * 136 + seg * 16) = k0; *(u32x4*)(Kb + r * 136 + seg * 16 + 8) = k1;
      *(u32x4*)(Qb + r * 136 + seg * 16) = q0; *(u32x4*)(Qb + r * 136 + seg * 16 + 8) = q1;
    }
    {
      const int ob = seg * 16 * 72 + (((r >> 3) ^ seg) << 3) + (r & 7);
      const int og = seg * 16 * 64 + r;
      const float sk = br * eg;
#pragma unroll
      for (int c = 0; c < 16; c++) {
        kdT_out[og + c * 64] = f2bf(kv[c] * ekd);
        KBGt[ob + c * 72] = f2bf(kv[c] * sk);
        VBt[ob + c * 72] = f2bf(vv[c] * br);
      }
    }
    for (int i = tid; i < 64 * 65; i += NT) Tf[i] = 0.f;
    __syncthreads();
    if (w < 4) {
      const int ti = w;
      f32x4 c4[4];
#pragma unroll
      for (int tj = 0; tj < 4; tj++) c4[tj] = f32x4{0.f, 0.f, 0.f, 0.f};
#pragma unroll
      for (int kk = 0; kk < 4; kk++) {
        bf16x8 a = ldfrag(Kb + (ti * 16 + (lane & 15)) * 136 + kk * 32 + (lane >> 4) * 8);
#pragma unroll
        for (int tj = 0; tj < 4; tj++) {
          bf16x8 bb = ldfrag(Kb + (tj * 16 + (lane & 15)) * 136 + kk * 32 + (lane >> 4) * 8);
          c4[tj] = mfma16(a, bb, c4[tj]);
        }
      }
#pragma unroll
      for (int tj = 0; tj < 4; tj++) {
        int j = tj * 16 + (lane & 15);
        float gj = gc[j];
#pragma unroll
        for (int rr = 0; rr < 4; rr++) {
          int i = ti * 16 + 4 * (lane >> 4) + rr;
          float v = (j < i) ? bt[i] * c4[tj][rr] * __expf(gc[i] - gj) : 0.f;
          Lf[i * 65 + j] = v;
        }
      }
    } else {
      const int ti = w - 4;
      f32x4 c4[4];
#pragma unroll
      for (int tj = 0; tj < 4; tj++) c4[tj] = f32x4{0.f, 0.f, 0.f, 0.f};
#pragma unroll
      for (int kk = 0; kk < 4; kk++) {
        bf16x8 bq = ldfrag(Qb + (ti * 16 + (lane & 15)) * 136 + kk * 32 + (lane >> 4) * 8);
#pragma unroll
        for (int tj = 0; tj < 4; tj++) {
          bf16x8 ak = ldfrag(Kb + (tj * 16 + (lane & 15)) * 136 + kk * 32 + (lane >> 4) * 8);
          c4[tj] = mfma16(ak, bq, c4[tj]);
        }
      }
      const int i = ti * 16 + (lane & 15);
      const float gi = gc[i];
      u16* intra_out = INTRA + (size_t)sidx * 4096;
#pragma unroll
      for (int tj = 0; tj < 4; tj++) {
        float o[4];
#pragma unroll
        for (int rr = 0; rr < 4; rr++) {
          int j = tj * 16 + 4 * (lane >> 4) + rr;
          o[rr] = (j <= i) ? c4[tj][rr] * __expf(gi - gc[j]) : 0.f;
        }
        u32x2 ov = {pack2(o[0], o[1]), pack2(o[2], o[3])};
        *(u32x2*)(intra_out + i * 64 + tj * 16 + 4 * (lane >> 4)) = ov;
      }
    }
    __syncthreads();
    if (tid < 64) {
      const int blk = tid >> 4, c = tid & 15;
      float x[16];
#pragma unroll
      for (int i = 0; i < 16; i++) {
        float s = (i == c) ? 1.f : 0.f;
#pragma unroll
        for (int j = 0; j < i; j++) s -= Lf[(blk * 16 + i) * 65 + blk * 16 + j] * x[j];
        x[i] = s;
      }
#pragma unroll
      for (int i = 0; i < 16; i++) Tf[(blk * 16 + i) * 65 + blk * 16 + c] = x[i];
    }
    __syncthreads();
    for (int dl = 1; dl < 4; dl++) {
      for (int bi = dl; bi < 4; bi++) {
        const int bj = bi - dl;
        const int rr = (tid >> 4) & 15, c = tid & 15;
        if (tid < 256) {
          float y = 0.f;
          for (int kk = bj * 16; kk < bi * 16; kk++) y += Lf[(bi * 16 + rr) * 65 + kk] * Tf[kk * 65 + bj * 16 + c];
          Ys[rr * 17 + c] = y;
        }
        __syncthreads();
        if (tid < 256) {
          float t = 0.f;
#pragma unroll
          for (int m = 0; m < 16; m++) t -= Tf[(bi * 16 + rr) * 65 + bi * 16 + m] * Ys[m * 17 + c];
          Tf[(bi * 16 + rr) * 65 + bj * 16 + c] = t;
        }
        __syncthreads();
      }
    }
    for (int i = tid; i < 4096; i += NT) { int ri = i >> 6, ci = i & 63; Tb[ri * 72 + ci] = f2bf(Tf[ri * 65 + ci]); }
    __syncthreads();
    {
      const bool isU = w >= 4;
      const int wq = w & 3;
      const u16* Xt = isU ? VBt : KBGt;
      u16* dst = NEGWU + (size_t)sidx * 16384 + (isU ? 8192 : 0);
#pragma unroll
      for (int tdl = 0; tdl < 2; tdl++) {
        const int td = wq * 2 + tdl;
        f32x4 c4[4];
#pragma unroll
        for (int ti = 0; ti < 4; ti++) c4[ti] = f32x4{0.f, 0.f, 0.f, 0.f};
#pragma unroll
        for (int kk = 0; kk < 2; kk++) {
          bf16x8 a = ldfrag(Xt + (td * 16 + (lane & 15)) * 72 + (((kk * 4 + (lane >> 4)) ^ td) << 3));
#pragma unroll
          for (int ti = 0; ti < 4; ti++) {
            bf16x8 bb = ldfrag(Tb + (ti * 16 + (lane & 15)) * 72 + kk * 32 + (lane >> 4) * 8);
            c4[ti] = isU ? mfma16(bb, a, c4[ti]) : mfma16(a, bb, c4[ti]);
          }
        }
        if (!isU) {
#pragma unroll
          for (int ti = 0; ti < 4; ti++) {
            int i = ti * 16 + (lane & 15), d = td * 16 + 4 * (lane >> 4);
            u32x2 ov = {pack2(-c4[ti][0], -c4[ti][1]), pack2(-c4[ti][2], -c4[ti][3])};
            *(u32x2*)(dst + i * 128 + d) = ov;
          }
        } else {
#pragma unroll
          for (int ti = 0; ti < 4; ti++) {
            int i = ti * 16 + 4 * (lane >> 4), d = td * 16 + (lane & 15);
            u32x2 ov = {pack2(c4[ti][0], c4[ti][1]), pack2(c4[ti][2], c4[ti][3])};
            *(u32x2*)(dst + d * 64 + i) = ov;
          }
        }
      }
    }
  }
}

struct ScanOps { bf16x8 a[4]; bf16x8 b[4]; bf16x8 ub; };

DI void scan_load(ScanOps& o, const u16* NEGWU, const u16* KDQG, const u16* INTRA, const float* GL, int item, int w, int lane, int e0) {
  const bool sw = w < 4;
  const int wq = w & 3;
  const u16* pa = sw ? NEGWU + (size_t)item * 16384 : KDQG + (size_t)item * 16384 + 8192;
  const u16* pb = sw ? KDQG + (size_t)item * 16384 : INTRA + (size_t)item * 4096;
  const int rowb = sw ? 32 * wq : 16 * wq, dstep = sw ? 16 : 0;
#pragma unroll
  for (int kk = 0; kk < 4; kk++) o.a[kk] = ldfrag(pa + (16 * wq + (lane & 15)) * 128 + kk * 32 + (lane >> 4) * 8);
#pragma unroll
  for (int dt = 0; dt < 2; dt++)
#pragma unroll
    for (int kk = 0; kk < 2; kk++) o.b[dt * 2 + kk] = ldfrag(pb + (rowb + dt * dstep + (lane & 15)) * 64 + kk * 32 + (lane >> 4) * 8);
  o.ub = ldfrag(NEGWU + (size_t)item * 16384 + 8192 + (e0 + (lane & 15)) * 64 + 16 * wq + 8 * ((lane >> 4) & 1));
}

DI void phase3_prompt(const P& p, char* smem, int id) {
  const int tid = threadIdx.x, lane = tid & 63, w = __builtin_amdgcn_readfirstlane(tid >> 6);
  const int x = id & 7, sl = (id >> 3) & 7, hi = id >> 6;
  const int bh = hi * 8 + x, b = bh >> 3, h = bh & 7, e0 = sl * 16;
  const u16* NEGWU = (const u16*)(p.out + O_KP);
  const u16* KDQG = (const u16*)(p.out + O_VP);
  const u16* INTRA = (const u16*)((const char*)p.out + 67633152);
  const float* GL = (const float*)(p.ws + WS_GL);
  u16* OA = (u16*)(p.ws + WS_OA);
  float* SSQ = (float*)(p.ws + WS_SSQ);
  u16* Sl = (u16*)smem;
  u16* Vn = Sl + 16 * 136;
  float* dec = (float*)(Vn + 16 * 72);
  u16* Os = (u16*)(dec + 256);
  __syncthreads();
  for (int i = tid; i < 16 * 136; i += NT) Sl[i] = 0;
  if (tid < 256) dec[tid] = GL[(b * 8 + h) * 256 + tid];
  f32x4 Sreg[2] = {f32x4{0.f, 0.f, 0.f, 0.f}, f32x4{0.f, 0.f, 0.f, 0.f}};
  bf16x8 identA;
#pragma unroll
  for (int j = 0; j < 8; j++) identA[j] = ((lane >> 4) < 2 && 8 * (lane >> 4) + j == (lane & 15)) ? (short)0x3F80 : (short)0;
  constexpr int NS = 4;
  ScanOps st[NS];
  __syncthreads();
  constexpr int GS = 16;
  for (int n0 = 0; n0 < 256; n0 += GS) {
#pragma unroll
    for (int j = 0; j < NS - 1; j++) scan_load(st[j], NEGWU, KDQG, INTRA, GL, (b * 8 + h) * 256 + n0 + j, w, lane, e0);
#pragma unroll
    for (int j = 0; j < GS; j++) {
      const int n = n0 + j;
      __builtin_amdgcn_sched_barrier(0);
      if (j + NS - 1 < GS) scan_load(st[(j + NS - 1) % NS], NEGWU, KDQG, INTRA, GL, (b * 8 + h) * 256 + n + NS - 1, w, lane, e0);
      __builtin_amdgcn_sched_barrier(0);
      const ScanOps& cur = st[j % NS];
      bf16x8 sf[4];
#pragma unroll
      for (int kk = 0; kk < 4; kk++) sf[kk] = ldfrag(Sl + (lane & 15) * 136 + kk * 32 + (lane >> 4) * 8);
      f32x4 acc = f32x4{0.f, 0.f, 0.f, 0.f};
      if (w < 4) acc = mfma16(identA, cur.ub, acc);
#pragma unroll
      for (int kk = 0; kk < 4; kk++) acc = mfma16(cur.a[kk], sf[kk], acc);
      if (w < 4) {
        u32x2 ov = {pack2(acc[0], acc[1]), pack2(acc[2], acc[3])};
        *(u32x2*)(Vn + (lane & 15) * 72 + 16 * w + 4 * (lane >> 4)) = ov;
      }
      __syncthreads();
      bf16x8 vf[2];
#pragma unroll
      for (int kk = 0; kk < 2; kk++) vf[kk] = ldfrag(Vn + (lane & 15) * 72 + kk * 32 + (lane >> 4) * 8);
      if (w < 4) {
#pragma unroll
        for (int dt = 0; dt < 2; dt++) {
          f32x4 sv = Sreg[dt];
          const float dcy = dec[n];
          sv[0] *= dcy; sv[1] *= dcy; sv[2] *= dcy; sv[3] *= dcy;
#pragma unroll
          for (int kk = 0; kk < 2; kk++) sv = mfma16(cur.b[dt * 2 + kk], vf[kk], sv);
          Sreg[dt] = sv;
          u32x2 ov = {pack2(sv[0], sv[1]), pack2(sv[2], sv[3])};
          *(u32x2*)(Sl + (lane & 15) * 136 + 32 * w + dt * 16 + 4 * (lane >> 4)) = ov;
        }
      } else {
#pragma unroll
        for (int kk = 0; kk < 2; kk++) acc = mfma16(cur.b[kk], vf[kk], acc);
        const int wq = w - 4;
#pragma unroll
        for (int rr = 0; rr < 4; rr++) Os[(16 * wq + 4 * (lane >> 4) + rr) * 16 + (lane & 15)] = f2bf(acc[rr]);
      }
      __syncthreads();
      {
        const u32 ov = ((const u32*)Os)[tid];
        const int row = tid >> 3, cp = tid & 7;
        const size_t tk = (size_t)(b * SEQ + n * 64 + row);
        *(u32*)(OA + tk * 1024 + h * 128 + e0 + cp * 2) = ov;
        float s2 = bflo(ov) * bflo(ov) + bfhi(ov) * bfhi(ov);
        s2 = DPP_ADD(s2, 0xB1); s2 = DPP_ADD(s2, 0x4E); s2 = DPP_ADD(s2, 0x124);
        if (cp == 4) SSQ[tk * 64 + h * 8 + sl] = s2;
      }
    }
  }
  if (w < 4) {
#pragma unroll
    for (int dt = 0; dt < 2; dt++)
#pragma unroll
      for (int rr = 0; rr < 4; rr++) {
        int d = 32 * w + dt * 16 + 4 * (lane >> 4) + rr;
        p.out[O_SP + ((size_t)(b * 8 + h) * 128 + d) * 128 + e0 + (lane & 15)] = Sreg[dt][rr];
      }
  }
}

DI void phase3_sample(const P& p, char* smem, int id) {
  const int tid = threadIdx.x, lane = tid & 63, w = tid >> 6;
  const int s = id >> 3, h = id & 7;
  const u16* QKV = (const u16*)(p.ws + WS_BIG);
  const float* BETA = (const float*)(p.ws + WS_BETA);
  const float* G = (const float*)(p.ws + WS_G);
  u16* OA = (u16*)(p.ws + WS_OA);
  float* SSQ = (float*)(p.ws + WS_SSQ);
  float* qkvs = (float*)smem;
  float* red = qkvs + 16 * 384;
  float* red2 = red + 512;
  float* osq = red2 + 512;
  __syncthreads();
  for (int idx = tid; idx < 16 * 384; idx += NT) {
    int t = idx / 384, c = idx % 384, mat = c >> 7, cc = c & 127, col = mat * 1024 + h * 128 + cc;
    float v = 0.f;
#pragma unroll
    for (int j = 0; j < 4; j++) {
      int tt = t - 3 + j;
      float e = tt < 0 ? p.state_conv[((size_t)s * 3 + (3 + tt)) * 3072 + col] : bf2f(QKV[(size_t)(TP + s * 16 + tt) * 3072 + col]);
      v += p.conv_w[j * 3072 + col] * e;
    }
    v = v / (1.f + __expf(-v));
    qkvs[t * 384 + c] = v;
  }
  __syncthreads();
  for (int i = 0; i < 4; i++) {
    int rr = w * 4 + i, t = rr >> 1, mat = rr & 1;
    float a0 = qkvs[t * 384 + mat * 128 + lane], a1 = qkvs[t * 384 + mat * 128 + 64 + lane];
    float ss = wave_sum(a0 * a0 + a1 * a1);
    float rinv = rsqrtf(ss + RMS_EPS) * (mat == 0 ? 0.08838834764831845f : 1.f);
    qkvs[t * 384 + mat * 128 + lane] = a0 * rinv;
    qkvs[t * 384 + mat * 128 + 64 + lane] = a1 * rinv;
  }
  __syncthreads();
  const int e = tid & 127, dq = tid >> 7;
  float S[32];
  const float* s0 = p.state_s + ((size_t)(s * 8 + h) * 128 + dq * 32) * 128 + e;
#pragma unroll
  for (int i = 0; i < 32; i++) S[i] = s0[(size_t)i * 128];
  for (int t = 0; t < 16; t++) {
    const int tok = TP + s * 16 + t;
    const float a = __expf(G[tok * 8 + h]), bb = BETA[tok * 8 + h];
    const float* qt = qkvs + t * 384;
    const float* kt = qt + 128;
    const float* vt = qt + 256;
    float r = 0.f;
#pragma unroll
    for (int i = 0; i < 32; i++) r += kt[dq * 32 + i] * S[i];
    red[dq * 128 + e] = r;
    __syncthreads();
    r = red[e] + red[128 + e] + red[256 + e] + red[384 + e];
    const float coef = bb * (vt[e] - a * r);
    float o = 0.f;
#pragma unroll
    for (int i = 0; i < 32; i++) { S[i] = a * S[i] + kt[dq * 32 + i] * coef; o += qt[dq * 32 + i] * S[i]; }
    red2[dq * 128 + e] = o;
    __syncthreads();
    if (dq == 0) {
      o = red2[e] + red2[128 + e] + red2[256 + e] + red2[384 + e];
      OA[(size_t)tok * 1024 + h * 128 + e] = f2bf(o);
      osq[e] = o * o;
    }
    __syncthreads();
    if (w == 0) {
      float s2 = wave_sum(osq[lane] + osq[64 + lane]);
      if (lane < 8) SSQ[(size_t)tok * 64 + h * 8 + lane] = lane == 0 ? s2 : 0.f;
    }
  }
  float* so = p.out + O_SS + ((size_t)(s * 8 + h) * 128 + dq * 32) * 128 + e;
#pragma unroll
  for (int i = 0; i < 32; i++) so[(size_t)i * 128] = S[i];
}

template <int TM>
DI void phase4_tile(const P& p, char* smem, int m0, int nt) {
  const u16* XN = (const u16*)p.out;
  const u16* WT = (const u16*)(p.ws + WS_WIN);
  u16* Qn = (u16*)(p.ws + WS_BIG);
  u16* Kn = (u16*)(p.ws + WS_BIG + BIG_KN);
  u16* Vt = (u16*)(p.ws + WS_BIG + BIG_VT);
  const int lane = threadIdx.x & 63, w = __builtin_amdgcn_readfirstlane(threadIdx.x >> 6), wm = w >> 1, wn = w & 1;
  {
    const u16* wbase = WT + (size_t)(C_FQ + nt * 128) * 1024;
    auto brow = [&](int r) { return wbase + (size_t)r * 1024; };
    f32x4 acc[TM][4];
    if (nt < 16) {
      gemm_main<128, false, true, 4, decltype(brow), TM>(XN, m0, brow, smem, acc);
      const bool isq = nt < 8;
      const int hh = nt & 7, m = wn;
      const float* gain = isq ? p.qn_g : p.kn_g;
#pragma unroll
      for (int i = 0; i < TM; i++) {
        int tok = m0 + wm * (TM * 16) + i * 16 + (lane & 15);
        float ss = 0.f;
#pragma unroll
        for (int j = 0; j < 4; j++)
#pragma unroll
          for (int rr = 0; rr < 4; rr++) ss += acc[i][j][rr] * acc[i][j][rr];
        ss += __shfl_xor(ss, 16); ss += __shfl_xor(ss, 32);
        float rinv = rsqrtf(ss * (1.f / 64.f) + RMS_EPS);
#pragma unroll
        for (int j = 0; j < 4; j++) {
          int dd = j * 16 + 4 * (lane >> 4);
          float4 g4 = *(const float4*)(gain + dd);
          float o0 = acc[i][j][0] * rinv * g4.x, o1 = acc[i][j][1] * rinv * g4.y, o2 = acc[i][j][2] * rinv * g4.z, o3 = acc[i][j][3] * rinv * g4.w;
          int col = hh * 128 + m * 64 + dd;
          if (isq) {
            u32x2 ov = {pack2(o0 * QSCALE, o1 * QSCALE), pack2(o2 * QSCALE, o3 * QSCALE)};
            *(u32x2*)(Qn + (size_t)tok * 1024 + col) = ov;
          } else {
            u32x2 ov = {pack2(o0, o1), pack2(o2, o3)};
            *(u32x2*)(Kn + (size_t)tok * 1024 + col) = ov;
            float* kd = tok < TP ? p.out + O_KP + (size_t)tok * 1024 + col : p.out + O_KS + (size_t)(tok - TP) * 1024 + col;
            __builtin_nontemporal_store(f32x4{o0, o1, o2, o3}, (f32x4*)kd);
          }
        }
      }
    } else {
      gemm_main<128, false, false, 4, decltype(brow), TM>(XN, m0, brow, smem, acc);
      const int hh = nt - 16;
#pragma unroll
      for (int i = 0; i < TM; i++) {
        int tok = m0 + wm * (TM * 16) + i * 16 + 4 * (lane >> 4);
#pragma unroll
        for (int j = 0; j < 4; j++) {
          int dv = wn * 64 + j * 16 + (lane & 15);
          f32x4 a = acc[i][j];
          u32x2 ov = {pack2(a[0], a[1]), pack2(a[2], a[3])};
          if (tok < TP) {
            int b = tok >> 14, tt = tok & 16383;
            *(u32x2*)(Vt + ((size_t)(b * 8 + hh) * 128 + dv) * SEQ + (tt & ~15) + 4 * VPERM((tt >> 2) & 3)) = ov;
#pragma unroll
            for (int rr = 0; rr < 4; rr++) __builtin_nontemporal_store(a[rr], &p.out[O_VP + (size_t)(tok + rr) * 1024 + hh * 128 + dv]);
          } else {
            int s = (tok - TP) >> 4, tt = tok & 15;
            *(u32x2*)(Vt + (size_t)33554432 + ((size_t)(s * 8 + hh) * 128 + dv) * 16 + 4 * VPERM((tt >> 2) & 3)) = ov;
#pragma unroll
            for (int rr = 0; rr < 4; rr++) __builtin_nontemporal_store(a[rr], &p.out[O_VS + (size_t)(tok - TP + rr) * 1024 + hh * 128 + dv]);
          }
        }
      }
    }
  }
}
DI void phase4(const P& p, char* smem, int bid, int nb, int nt0, int ntw) {
  for (int t = bid; t < 128 * ntw; t += nb) phase4_tile<4>(p, smem, (t / ntw) * 256, nt0 + t % ntw);
  for (int t = bid; t < 4 * ntw; t += nb) phase4_tile<1>(p, smem, TP + (t / ntw) * 64, nt0 + t % ntw);
}

DI float calc_lam(const P& p, int lane) {
  float a = wave_sum(p.lq1[lane] * p.lk1[lane]);
  float b = wave_sum(p.lq2[lane] * p.lk2[lane]);
  return __expf(a) - __expf(b) + LAM_INIT;
}
DI float calc_m2(const P& p, int lane) {
  float gq = wave_max(fabsf(p.qn_g[lane])), gk = wave_max(fabsf(p.kn_g[lane]));
  return 8.f * gq * gk * LOG2E * 1.03f + 0.1f;
}

DI void attn_prompt(const P& p, char* smem, int bh, int qb, float lam, float M2) {
  const int tid = threadIdx.x, lane = tid & 63, w = __builtin_amdgcn_readfirstlane(tid >> 6);
  const int sub = w >> 1, map = w & 1, b = bh >> 3, h = bh & 7;
  const int l31 = lane & 31, hf = lane >> 5;
  const u16* Qn = (const u16*)(p.ws + WS_BIG);
  const u16* Kn = (const u16*)(p.ws + WS_BIG + BIG_KN);
  const u16* Vt = (const u16*)(p.ws + WS_BIG + BIG_VT);
  u16* OB = (u16*)(p.ws + WS_OB);
  const int tok0 = b * SEQ + qb * 128;
  const int ntile = 2 * qb + 2;
  const int my_nt = 2 * qb + 1 + (sub >> 1);
  constexpr int TILEB = 32768;
  bf16x8 qf[4];
#pragma unroll
  for (int kk = 0; kk < 4; kk++) qf[kk] = ldfrag(Qn + (size_t)(tok0 + 32 * sub + l31) * 1024 + h * 128 + map * 64 + kk * 16 + hf * 8);
  f32x16 ot[4];
#pragma unroll
  for (int dt = 0; dt < 4; dt++)
#pragma unroll
    for (int i = 0; i < 16; i++) ot[dt][i] = 0.f;
  f32x16 zinit;
#pragma unroll
  for (int i = 0; i < 16; i++) zinit[i] = 0.f;
  float lsum = 0.f;
  const u16* kbase = Kn + (size_t)(b * SEQ) * 1024 + h * 128;
  const u16* vbase = Vt + (size_t)(b * 8 + h) * 128 * SEQ;
  const u16* gsrc[4];
#pragma unroll
  for (int ii = 0; ii < 4; ii++) {
    int r = (w * 4 + ii) * 8 + (lane >> 3), pos = lane & 7, c = pos ^ ((r >> 1) & 7);
    if (w < 4) { int key = r & 63, m = r >> 6; gsrc[ii] = kbase + (size_t)key * 1024 + m * 64 + c * 8; }
    else { int dv = r - 128; gsrc[ii] = vbase + (size_t)dv * SEQ + c * 8; }
  }
  const size_t gstep = w < 4 ? (size_t)64 * 1024 : (size_t)64;
  auto glds = [&](int kt, int bufi) {
    char* dst = smem + bufi * TILEB + w * 4096;
#pragma unroll
    for (int ii = 0; ii < 4; ii++)
      __builtin_amdgcn_global_load_lds((const unsigned*)(gsrc[ii] + (size_t)kt * gstep), (unsigned*)(dst + ii * 1024), 16, 0, 0);
  };
  const int swz16 = ((l31 >> 1) & 7) << 4;
  const int krow = (map * 64 + l31) * 128, vrow = (128 + l31) * 128;
  __syncthreads();
  asm volatile("s_waitcnt vmcnt(0)" ::: "memory");
  glds(0, 0);
  glds(1, 1);
  for (int kt = 0; kt < ntile; kt++) {
    if (kt + 1 < ntile) asm volatile("s_waitcnt vmcnt(4)" ::: "memory");
    else asm volatile("s_waitcnt vmcnt(0)" ::: "memory");
    RAW_BARRIER();
    if (kt + 2 < ntile) glds(kt + 2, (kt + 2) % 3);
    if (kt < my_nt) {
      const char* buf = smem + (kt % 3) * TILEB;
      bf16x8 kf[2][4];
#pragma unroll
      for (int tk = 0; tk < 2; tk++)
#pragma unroll
        for (int kk = 0; kk < 4; kk++) kf[tk][kk] = *(const bf16x8*)(buf + krow + tk * 4096 + (((kk * 2 + hf) << 4) ^ swz16));
      __builtin_amdgcn_sched_barrier(0);
      f32x16 st[2];
#pragma unroll
      for (int kk = 0; kk < 4; kk++)
#pragma unroll
        for (int tk = 0; tk < 2; tk++) st[tk] = mfma32(kf[tk][kk], qf[kk], kk == 0 ? zinit : st[tk]);
      __builtin_amdgcn_sched_barrier(0);
      bf16x8 vf0[4], vf1[4];
#pragma unroll
      for (int c4 = 0; c4 < 4; c4++) vf0[c4] = *(const bf16x8*)(buf + vrow + 0 * 4096 + (((c4 * 2 + hf) << 4) ^ swz16));
      __builtin_amdgcn_sched_barrier(0);
      bf16x8 pf[4];
#pragma unroll
      for (int tk = 0; tk < 2; tk++) {
        float pe[16];
#pragma unroll
        for (int i = 0; i < 16; i++) { pe[i] = __builtin_amdgcn_exp2f(st[tk][i]); lsum += pe[i]; }
#pragma unroll
        for (int s2 = 0; s2 < 2; s2++) {
          u32x4 pk = {pack2(pe[8 * s2], pe[8 * s2 + 1]), pack2(pe[8 * s2 + 2], pe[8 * s2 + 3]), pack2(pe[8 * s2 + 4], pe[8 * s2 + 5]), pack2(pe[8 * s2 + 6], pe[8 * s2 + 7])};
          pf[tk * 2 + s2] = __builtin_bit_cast(bf16x8, pk);
        }
      }
      __builtin_amdgcn_sched_barrier(0);
#pragma unroll
      for (int c4 = 0; c4 < 4; c4++) vf1[c4] = *(const bf16x8*)(buf + vrow + 1 * 4096 + (((c4 * 2 + hf) << 4) ^ swz16));
      __builtin_amdgcn_sched_barrier(0);
#pragma unroll
      for (int c4 = 0; c4 < 4; c4++) ot[0] = mfma32(vf0[c4], pf[c4], ot[0]);
      __builtin_amdgcn_sched_barrier(0);
#pragma unroll
      for (int c4 = 0; c4 < 4; c4++) vf0[c4] = *(const bf16x8*)(buf + vrow + 2 * 4096 + (((c4 * 2 + hf) << 4) ^ swz16));
      __builtin_amdgcn_sched_barrier(0);
#pragma unroll
      for (int c4 = 0; c4 < 4; c4++) ot[1] = mfma32(vf1[c4], pf[c4], ot[1]);
      __builtin_amdgcn_sched_barrier(0);
#pragma unroll
      for (int c4 = 0; c4 < 4; c4++) vf1[c4] = *(const bf16x8*)(buf + vrow + 3 * 4096 + (((c4 * 2 + hf) << 4) ^ swz16));
      __builtin_amdgcn_sched_barrier(0);
#pragma unroll
      for (int c4 = 0; c4 < 4; c4++) ot[2] = mfma32(vf0[c4], pf[c4], ot[2]);
      __builtin_amdgcn_sched_barrier(0);
#pragma unroll
      for (int c4 = 0; c4 < 4; c4++) ot[3] = mfma32(vf1[c4], pf[c4], ot[3]);
      __builtin_amdgcn_sched_barrier(0);
    }
  }
  __syncthreads();
  lsum += __shfl_xor(lsum, 32);
  const float linv = 1.f / lsum;
  float* Xs = (float*)smem;
  if (map == 1) {
#pragma unroll
    for (int dt = 0; dt < 4; dt++)
#pragma unroll
      for (int i = 0; i < 16; i++) Xs[(sub * 64 + dt * 16 + i) * 64 + lane] = ot[dt][i] * linv;
  }
  __syncthreads();
  if (map == 0) {
    float ss = 0.f;
#pragma unroll
    for (int dt = 0; dt < 4; dt++)
#pragma unroll
      for (int i = 0; i < 16; i++) {
        float v = ot[dt][i] * linv - lam * Xs[(sub * 64 + dt * 16 + i) * 64 + lane];
        ot[dt][i] = v;
        ss += v * v;
      }
    ss += __shfl_xor(ss, 32);
    const float rinv = rsqrtf(ss * (1.f / 128.f) + RMS_EPS) * (1.f - LAM_INIT);
    u16* orow = OB + (size_t)(tok0 + 32 * sub + l31) * 1024 + h * 128;
#pragma unroll
    for (int dt = 0; dt < 4; dt++)
#pragma unroll
      for (int g = 0; g < 4; g++) {
        int dv = dt * 32 + 8 * g + 4 * hf;
        float4 g4 = *(const float4*)(p.diff_norm_g + dv);
        u32x2 ov = {pack2(ot[dt][4 * g] * rinv * g4.x, ot[dt][4 * g + 1] * rinv * g4.y), pack2(ot[dt][4 * g + 2] * rinv * g4.z, ot[dt][4 * g + 3] * rinv * g4.w)};
        *(u32x2*)(orow + dv) = ov;
      }
  }
  __syncthreads();
}

DI void attn_sample(const P& p, char* smem, int s, int h, float lam, float M2) {
  const int tid = threadIdx.x, lane = tid & 63, w = tid >> 6;
  const u16* Qn = (const u16*)(p.ws + WS_BIG);
  const u16* Kn = (const u16*)(p.ws + WS_BIG + BIG_KN);
  const u16* VtS = (const u16*)(p.ws + WS_BIG + BIG_VT) + (size_t)33554432;
  u16* OB = (u16*)(p.ws + WS_OB);
  float* qs = (float*)smem;
  float* Ps = qs + 2048;
  float* Os = Ps + 2048;
  float* Kt = Os + 2048;
  float* Vl = Kt + 64 * 132;
  __syncthreads();
  for (int i = tid; i < 2048; i += NT) {
    int m = i >> 10, q = (i >> 6) & 15, d = i & 63;
    qs[i] = bf2f(Qn[(size_t)(TP + s * 16 + q) * 1024 + h * 128 + m * 64 + d]);
  }
  const int key = tid & 63, grp = tid >> 6, map = grp & 1, q0 = 4 * (grp >> 1);
  const int dv = tid & 127, qg = tid >> 7;
  float acc[2][4], ls[2][4];
#pragma unroll
  for (int m = 0; m < 2; m++)
#pragma unroll
    for (int qq = 0; qq < 4; qq++) { acc[m][qq] = 0.f; ls[m][qq] = 0.f; }
  float4 rk0, rk1, rk2, rk3, rv0, rv1, rv2, rv3;
#define SGLOAD(kt_)                                                                                         \
  {                                                                                                         \
    size_t off = (((size_t)s * 1024 + (kt_) * 64 + (tid >> 5)) * 8 + h) * 128 + (tid & 31) * 4;             \
    rk0 = *(const float4*)(p.cache_k + off); rv0 = *(const float4*)(p.cache_v + off);                       \
    rk1 = *(const float4*)(p.cache_k + off + 16 * 1024); rv1 = *(const float4*)(p.cache_v + off + 16 * 1024); \
    rk2 = *(const float4*)(p.cache_k + off + 32 * 1024); rv2 = *(const float4*)(p.cache_v + off + 32 * 1024); \
    rk3 = *(const float4*)(p.cache_k + off + 48 * 1024); rv3 = *(const float4*)(p.cache_v + off + 48 * 1024); \
  }
  SGLOAD(0)
  for (int kt = 0; kt < 17; kt++) {
    const int nvalid = kt < 16 ? 64 : 16;
    __syncthreads();
    if (kt < 16) {
      {
        int kk = tid >> 5, c4 = tid & 31;
        *(float4*)(Kt + kk * 132 + c4 * 4) = rk0; *(float4*)(Vl + kk * 128 + c4 * 4) = rv0;
        *(float4*)(Kt + (kk + 16) * 132 + c4 * 4) = rk1; *(float4*)(Vl + (kk + 16) * 128 + c4 * 4) = rv1;
        *(float4*)(Kt + (kk + 32) * 132 + c4 * 4) = rk2; *(float4*)(Vl + (kk + 32) * 128 + c4 * 4) = rv2;
        *(float4*)(Kt + (kk + 48) * 132 + c4 * 4) = rk3; *(float4*)(Vl + (kk + 48) * 128 + c4 * 4) = rv3;
      }
      if (kt + 1 < 16) SGLOAD(kt + 1)
    } else {
      for (int i = tid; i < 16 * 128; i += NT) {
        int kk = i >> 7, c = i & 127;
        Kt[kk * 132 + c] = bf2f(Kn[(size_t)(TP + s * 16 + kk) * 1024 + h * 128 + c]);
        Vl[kk * 128 + c] = bf2f(VtS[((size_t)(s * 8 + h) * 128 + c) * 16 + 4 * VPERM((kk >> 2) & 3) + (kk & 3)]);
      }
    }
    __syncthreads();
    float d0 = 0.f, d1 = 0.f, d2 = 0.f, d3 = 0.f;
    {
      const float* qp = qs + (map * 16 + q0) * 64;
#pragma unroll
      for (int c = 0; c < 16; c++) {
        float4 kv = *(const float4*)(Kt + key * 132 + map * 64 + c * 4);
        float4 a0 = *(const float4*)(qp + c * 4), a1 = *(const float4*)(qp + 64 + c * 4), a2 = *(const float4*)(qp + 128 + c * 4), a3 = *(const float4*)(qp + 192 + c * 4);
        d0 += kv.x * a0.x + kv.y * a0.y + kv.z * a0.z + kv.w * a0.w;
        d1 += kv.x * a1.x + kv.y * a1.y + kv.z * a1.z + kv.w * a1.w;
        d2 += kv.x * a2.x + kv.y * a2.y + kv.z * a2.z + kv.w * a2.w;
        d3 += kv.x * a3.x + kv.y * a3.y + kv.z * a3.z + kv.w * a3.w;
      }
    }
    {
      const bool ok = key < nvalid;
      float* pp = Ps + (map * 16 + q0) * 64 + key;
      pp[0] = ok ? __builtin_amdgcn_exp2f(d0 - M2) : 0.f;
      pp[64] = ok ? __builtin_amdgcn_exp2f(d1 - M2) : 0.f;
      pp[128] = ok ? __builtin_amdgcn_exp2f(d2 - M2) : 0.f;
      pp[192] = ok ? __builtin_amdgcn_exp2f(d3 - M2) : 0.f;
    }
    __syncthreads();
    for (int k2 = 0; k2 < nvalid; k2++) {
      float v = Vl[k2 * 128 + dv];
#pragma unroll
      for (int m = 0; m < 2; m++)
#pragma unroll
        for (int qq = 0; qq < 4; qq++) {
          float pp = Ps[(m * 16 + 4 * qg + qq) * 64 + k2];
          acc[m][qq] += pp * v;
          ls[m][qq] += pp;
        }
    }
  }
#pragma unroll
  for (int qq = 0; qq < 4; qq++) Os[(4 * qg + qq) * 128 + dv] = acc[0][qq] / ls[0][qq] - lam * acc[1][qq] / ls[1][qq];
  __syncthreads();
  for (int i = 0; i < 2; i++) {
    int q = w * 2 + i;
    float a0 = Os[q * 128 + lane], a1 = Os[q * 128 + 64 + lane];
    float ss = wave_sum(a0 * a0 + a1 * a1);
    float rinv = rsqrtf(ss * (1.f / 128.f) + RMS_EPS) * (1.f - LAM_INIT);
    u16* orow = OB + (size_t)(TP + s * 16 + q) * 1024 + h * 128;
    orow[lane] = f2bf(a0 * rinv * p.diff_norm_g[lane]);
    orow[64 + lane] = f2bf(a1 * rinv * p.diff_norm_g[64 + lane]);
  }
  __syncthreads();
}

DI void phase5(const P& p, char* smem, int bid, int nb) {
  const int lane = threadIdx.x & 63;
  const float lam = calc_lam(p, lane);
  const float M2 = calc_m2(p, lane);
  const int nitems = 2048 + 128;
  for (int k = 0;; k++) {
    int x = (k & 1) ? (nb - 1 - bid) : bid;
    int id = k * nb + x;
    if (k * nb >= nitems) break;
    if (id >= nitems) continue;
    if (id < 2048) {
      int bh = (id & 7) + 8 * ((id >> 3) & 1), qb = 127 - (id >> 4);
      attn_prompt(p, smem, bh, qb, lam, M2);
    } else {
      int sid = id - 2048;
      attn_sample(p, smem, sid >> 3, sid & 7, lam, M2);
    }
  }
}

template <int TM>
DI void phase6_tile(const P& p, char* smem, int m0, int n0) {
  const u16* XN = (const u16*)p.out;
  const u16* WT = (const u16*)(p.ws + WS_WIN);
  u16* OA = (u16*)(p.ws + WS_OA);
  const u16* OB = (const u16*)(p.ws + WS_OB);
  const float* SSQ = (const float*)(p.ws + WS_SSQ);
  const int lane = threadIdx.x & 63, w = __builtin_amdgcn_readfirstlane(threadIdx.x >> 6), wm = w >> 1, wn = w & 1;
  {
    f32x4 acc[TM][6];
    auto brow = [&](int r) {
      int seg = r >> 6, c = r & 63;
      int col = (seg == 0 ? C_Z : (seg == 1 ? C_GA : C_GB)) + n0 + c;
      return WT + (size_t)col * 1024; };
    gemm_main<192, true, true, 6, decltype(brow), TM>(XN, m0, brow, smem, acc);
    const int head = n0 >> 7;
#pragma unroll
    for (int i = 0; i < TM; i++) {
      int tok = m0 + wm * (TM * 16) + i * 16 + (lane & 15);
      const float4* sp = (const float4*)(SSQ + (size_t)tok * 64 + head * 8);
      float4 s0 = sp[0], s1 = sp[1];
      float ssq = s0.x + s0.y + s0.z + s0.w + s1.x + s1.y + s1.z + s1.w;
      float rinv = rsqrtf(ssq * (1.f / 128.f) + RMS_EPS);
#pragma unroll
      for (int jj = 0; jj < 2; jj++) {
        int ch = n0 + wn * 32 + jj * 16 + 4 * (lane >> 4);
        u32x2 oa = *(const u32x2*)(OA + (size_t)tok * 1024 + ch);
        u32x2 ob = *(const u32x2*)(OB + (size_t)tok * 1024 + ch);
        float4 g4 = *(const float4*)(p.delta_norm_g + (ch & 127));
        float av[4] = {bflo(oa[0]), bfhi(oa[0]), bflo(oa[1]), bfhi(oa[1])};
        float bv[4] = {bflo(ob[0]), bfhi(ob[0]), bflo(ob[1]), bfhi(ob[1])};
        float gv[4] = {g4.x, g4.y, g4.z, g4.w};
        float o[4];
#pragma unroll
        for (int rr = 0; rr < 4; rr++) {
          float z = acc[i][jj][rr], ga = acc[i][2 + jj][rr], gb = acc[i][4 + jj][rr];
          float oan = av[rr] * rinv * gv[rr] * (z / (1.f + __expf(-z)));
          o[rr] = sigmoidf_(ga) * oan + sigmoidf_(gb) * bv[rr];
        }
        u32x2 ov = {pack2(o[0], o[1]), pack2(o[2], o[3])};
        *(u32x2*)(OA + (size_t)tok * 1024 + ch) = ov;
      }
    }
  }
}
DI void phase6(const P& p, char* smem, int bid, int nb) {
  for (int t = bid; t < 128 * 16; t += nb) phase6_tile<4>(p, smem, (t / 16) * 256, (t % 16) * 64);
  for (int t = bid; t < 4 * 16; t += nb) phase6_tile<1>(p, smem, TP + (t / 16) * 64, (t % 16) * 64);
}

template <int TM>
DI void phase7_tile(const P& p, char* smem, int m0, int n0) {
  const u16* MG = (const u16*)(p.ws + WS_OA);
  const u16* WT = (const u16*)(p.ws + WS_WOUT);
  const int lane = threadIdx.x & 63, w = __builtin_amdgcn_readfirstlane(threadIdx.x >> 6), wm = w >> 1, wn = w & 1;
  f32x4 acc[TM][4];
  auto brow = [&](int r) { return WT + (size_t)(n0 + r) * 1024; };
  gemm_main<128, false, true, 4, decltype(brow), TM>(MG, m0, brow, smem, acc);
#pragma unroll
  for (int i = 0; i < TM; i++) {
    int tok = m0 + wm * (TM * 16) + i * 16 + (lane & 15);
    const float* xr = tok < TP ? p.x_prompt + (size_t)tok * D : p.x_sample + (size_t)(tok - TP) * D;
#pragma unroll
    for (int j = 0; j < 4; j++) {
      int n = n0 + wn * 64 + j * 16 + 4 * (lane >> 4);
      float4 xv = *(const float4*)(xr + n);
      f32x4 a = acc[i][j];
      *(float4*)(p.out + (size_t)tok * 1024 + n) = make_float4(xv.x + a[0], xv.y + a[1], xv.z + a[2], xv.w + a[3]);
    }
  }
}
DI void phase7(const P& p, char* smem, int bid, int nb) {
  for (int t = bid; t < 128 * 8; t += nb) phase7_tile<4>(p, smem, (t / 8) * 256, (t % 8) * 128);
  for (int t = bid; t < 4 * 8; t += nb) phase7_tile<1>(p, smem, TP + (t / 8) * 64, (t % 8) * 128);
}

DI void conv_fp8_rows(const float* __restrict__ src, u32* __restrict__ dst8, float* __restrict__ inv_scale, int gw, int gws, int lane) {
  for (int row = gw; row < 16384; row += gws) {
    const float4* rp = (const float4*)(src + (size_t)row * 1024 + lane * 16);
    float4 a0 = rp[0], a1 = rp[1], a2 = rp[2], a3 = rp[3];
    float m = fmaxf(fmaxf(fmaxf(fabsf(a0.x), fabsf(a0.y)), fmaxf(fabsf(a0.z), fabsf(a0.w))), fmaxf(fmaxf(fabsf(a1.x), fabsf(a1.y)), fmaxf(fabsf(a1.z), fabsf(a1.w))));
    m = fmaxf(m, fmaxf(fmaxf(fmaxf(fabsf(a2.x), fabsf(a2.y)), fmaxf(fabsf(a2.z), fabsf(a2.w))), fmaxf(fmaxf(fabsf(a3.x), fabsf(a3.y)), fmaxf(fabsf(a3.z), fabsf(a3.w)))));
    m = wave_max(m);
    float sc = m > 0.f ? exp2f(floorf(log2f(448.f / m))) : 1.f;
    u32x4 o;
    int t;
    t = __builtin_amdgcn_cvt_pk_fp8_f32(a0.x * sc, a0.y * sc, 0, false); t = __builtin_amdgcn_cvt_pk_fp8_f32(a0.z * sc, a0.w * sc, t, true); o[0] = (u32)t;
    t = __builtin_amdgcn_cvt_pk_fp8_f32(a1.x * sc, a1.y * sc, 0, false); t = __builtin_amdgcn_cvt_pk_fp8_f32(a1.z * sc, a1.w * sc, t, true); o[1] = (u32)t;
    t = __builtin_amdgcn_cvt_pk_fp8_f32(a2.x * sc, a2.y * sc, 0, false); t = __builtin_amdgcn_cvt_pk_fp8_f32(a2.z * sc, a2.w * sc, t, true); o[2] = (u32)t;
    t = __builtin_amdgcn_cvt_pk_fp8_f32(a3.x * sc, a3.y * sc, 0, false); t = __builtin_amdgcn_cvt_pk_fp8_f32(a3.z * sc, a3.w * sc, t, true); o[3] = (u32)t;
    *(u32x4*)(dst8 + (size_t)row * 256 + lane * 4) = o;
    if (lane == 0) inv_scale[row] = 1.f / sc;
  }
}

DI void phase8(const P& p, int bid, int nb) {
  const int lane = threadIdx.x & 63, w = threadIdx.x >> 6;
  u16* HN = (u16*)(p.ws + WS_OB);
#pragma unroll 2
  for (int row = bid * 8 + w; row < TT; row += nb * 8) {
    const float* hr = p.out + (size_t)row * 1024;
    float4 v[4];
    float ss = 0.f;
#pragma unroll
    for (int i = 0; i < 4; i++) { v[i] = *(const float4*)(hr + i * 256 + lane * 4); ss += v[i].x * v[i].x + v[i].y * v[i].y + v[i].z * v[i].z + v[i].w * v[i].w; }
    ss = wave_sum(ss);
    float rinv = rsqrtf(ss * (1.f / 1024.f) + RMS_EPS);
#pragma unroll
    for (int i = 0; i < 4; i++) {
      float4 g4 = *(const float4*)(p.norm_ffn_g + i * 256 + lane * 4);
      u32x2 o = {pack2(v[i].x * rinv * g4.x, v[i].y * rinv * g4.y), pack2(v[i].z * rinv * g4.z, v[i].w * rinv * g4.w)};
      *(u32x2*)(HN + (size_t)row * 1024 + i * 256 + lane * 4) = o;
    }
  }
}

DI u32 mono_key(float s, int n) {
  u32 b = __float_as_uint(s);
  u32 m = b ^ ((b >> 31) ? 0xFFFFFFFFu : 0x80000000u);
  return (m & 0xFFFFFF80u) | (u32)n;
}
DI float mono_val(u32 k) {
  u32 m = k & 0xFFFFFF80u;
  u32 b = (m & 0x80000000u) ? (m ^ 0x80000000u) : ~m;
  return __uint_as_float(b);
}
DI void top_insert(u32 (&t)[16], u32 x) {
#pragma unroll
  for (int i = 15; i >= 0; i--) { u32 hi = max(t[i], x), lo = min(t[i], x); t[i] = hi; x = lo; }
}
DI void top_insert_desc(u32 (&t)[16], u32 x) {
#pragma unroll
  for (int i = 0; i < 16; i++) { u32 hi = max(t[i], x), lo = min(t[i], x); t[i] = hi; x = lo; }
}

DI void ce_desc(u32& a, u32& b) { u32 hi = max(a, b), lo = min(a, b); a = hi; b = lo; }
DI void bitonic_sort16_desc(u32 (&a)[16]) {
#pragma unroll
  for (int k = 2; k <= 16; k <<= 1)
#pragma unroll
    for (int j = k >> 1; j > 0; j >>= 1)
#pragma unroll
      for (int i = 0; i < 16; i++) {
        const int l = i ^ j;
        if (l > i) { if ((i & k) == 0) ce_desc(a[i], a[l]); else ce_desc(a[l], a[i]); }
      }
}
DI void merge_top16_desc(u32 (&t)[16], const u32 (&b)[16]) {
#pragma unroll
  for (int i = 0; i < 16; i++) t[i] = max(t[i], b[15 - i]);
#pragma unroll
  for (int j = 8; j > 0; j >>= 1)
#pragma unroll
    for (int i = 0; i < 16; i++) { const int l = i ^ j; if (l > i) ce_desc(t[i], t[l]); }
}

template <int TM>
DI void phase9_tile(const P& p, char* smem, int m0, int nt) {
  const u16* HN = (const u16*)(p.ws + WS_OB);
  const u16* WT = (const u16*)(p.ws + WS_WQ);
  const u16* SK = (const u16*)(p.ws + WS_SK);
  u32* SEL = (u32*)(p.ws + WS_SEL);
  const int tid = threadIdx.x, lane = tid & 63, w = __builtin_amdgcn_readfirstlane(tid >> 6), wm = w >> 1, wn = w & 1;
  u16* Qs = (u16*)smem;
  u16* Ks = Qs + 256 * 136;
  u32* Sc = (u32*)smem;
  const int n0 = nt * 128;
  {
    f32x4 acc[TM][4];
    auto brow = [&](int r) { return WT + (size_t)(n0 + r) * 1024; };
    gemm_main<128, false, true, 4, decltype(brow), TM>(HN, m0, brow, smem, acc);
#pragma unroll
    for (int i = 0; i < TM; i++)
#pragma unroll
      for (int j = 0; j < 4; j++) {
        int tl = wm * (TM * 16) + i * 16 + (lane & 15), d = wn * 64 + j * 16 + 4 * (lane >> 4);
        u32x2 ov = {pack2(acc[i][j][0], acc[i][j][1]), pack2(acc[i][j][2], acc[i][j][3])};
        *(u32x2*)(Qs + tl * 136 + d) = ov;
      }
#pragma unroll
    for (int i = 0; i < 4; i++) {
      int c = tid + 512 * i, n = c >> 4, d8 = c & 15;
      *(u32x4*)(Ks + n * 136 + d8 * 8) = *(const u32x4*)(SK + (size_t)(nt * 128 + n) * 128 + d8 * 8);
    }
    __syncthreads();
#pragma unroll
    for (int i = 0; i < TM; i++)
#pragma unroll
      for (int j = 0; j < 4; j++) acc[i][j] = f32x4{0.f, 0.f, 0.f, 0.f};
#pragma unroll
    for (int kk = 0; kk < 4; kk++) {
      bf16x8 qfr[TM], kfr[4];
#pragma unroll
      for (int i = 0; i < TM; i++) qfr[i] = ldfrag(Qs + (wm * (TM * 16) + i * 16 + (lane & 15)) * 136 + kk * 32 + (lane >> 4) * 8);
#pragma unroll
      for (int j = 0; j < 4; j++) kfr[j] = ldfrag(Ks + (wn * 64 + j * 16 + (lane & 15)) * 136 + kk * 32 + (lane >> 4) * 8);
#pragma unroll
      for (int i = 0; i < TM; i++)
#pragma unroll
        for (int j = 0; j < 4; j++) acc[i][j] = mfma16(kfr[j], qfr[i], acc[i][j]);
    }
    __syncthreads();
#pragma unroll
    for (int i = 0; i < TM; i++)
#pragma unroll
      for (int j = 0; j < 4; j++)
#pragma unroll
        for (int rr = 0; rr < 4; rr++) {
          int tl = wm * (TM * 16) + i * 16 + (lane & 15), n = wn * 64 + j * 16 + 4 * (lane >> 4) + rr;
          Sc[tl * 129 + n] = mono_key(acc[i][j][rr], n);
        }
    __syncthreads();
    {
      const int row = tid & 255, half = tid >> 8;
      const bool rowok = row < TM * 64;
      u32 tk[16];
      const u32* src = Sc + (rowok ? row : 0) * 129 + half * 64;
#pragma unroll
      for (int i = 0; i < 16; i++) tk[i] = src[i];
      bitonic_sort16_desc(tk);
#pragma nounroll
      for (int blk = 1; blk < 4; blk++) {
        u32 bk[16];
#pragma unroll
        for (int i = 0; i < 16; i++) bk[i] = src[blk * 16 + i];
        bitonic_sort16_desc(bk);
        merge_top16_desc(tk, bk);
      }
      if (half == 1 && rowok) {
#pragma unroll
        for (int i = 0; i < 16; i++) Sc[row * 129 + 64 + i] = tk[i];
      }
      __syncthreads();
      if (half == 0 && rowok) {
        u32 bk[16];
#pragma unroll
        for (int i = 0; i < 16; i++) bk[i] = Sc[row * 129 + 64 + i];
        merge_top16_desc(tk, bk);
        u32* dst = SEL + ((size_t)(m0 + row) * 16 + nt) * 16;
#pragma unroll
        for (int i = 0; i < 4; i++) { u32x4 o = {tk[4 * i], tk[4 * i + 1], tk[4 * i + 2], tk[4 * i + 3]}; *(u32x4*)(dst + 4 * i) = o; }
      }
    }
    __syncthreads();
  }
}
DI void phase9(const P& p, char* smem, int bid, int nb) {
  for (int t = bid; t < 128 * 16; t += nb) phase9_tile<4>(p, smem, (t / 16) * 256, t % 16);
  for (int t = bid; t < 4 * 16; t += nb) phase9_tile<1>(p, smem, TP + (t / 16) * 64, t % 16);
}

__device__ const unsigned char PAIR_I[64] = {0,0,0,0,0,0,0,0,0,0,0,0,0,0,0,0, 1,1,1,1,1,1,1,1, 2,2,2,2,2, 3,3,3,3, 4,4,4, 5,5, 6,6, 7,7, 8,9,10,11,12,13,14,15, 0,0,0,0,0,0,0,0,0,0,0,0,0,0};
__device__ const unsigned char PAIR_J[64] = {0,1,2,3,4,5,6,7,8,9,10,11,12,13,14,15, 0,1,2,3,4,5,6,7, 0,1,2,3,4, 0,1,2,3, 0,1,2, 0,1, 0,1, 0,1, 0,0,0,0,0,0,0,0, 0,0,0,0,0,0,0,0,0,0,0,0,0,0};

struct PeerGrp { u32x4 ua[4], va[4]; float usl, vsl; };
DI f32x2 fp8lo(u32 w) { return __builtin_amdgcn_cvt_pk_f32_fp8((int)w, false); }
DI f32x2 fp8hi(u32 w) { return __builtin_amdgcn_cvt_pk_f32_fp8((int)w, true); }

template <bool DRY>
DI void phase10(const P& p, char* smem, int bid, int nb) {
  const int tid = threadIdx.x, lane = tid & 63, w = tid >> 6;
  const u16* HN = (const u16*)(p.ws + WS_OB);
  const u32* U8 = (const u32*)(p.ws + WS_U);
  const u32* V8 = (const u32*)(p.ws + WS_U + 16777216);
  const float* USC = (const float*)(p.ws + WS_V);
  const float* VSC = (const float*)(p.ws + WS_V + 65536);
  const u32* SEL = (const u32*)(p.ws + WS_SEL);
  int* le = (int*)smem + w * 512;
  float* lg = (float*)(le + 128);
  u32* selbuf = (u32*)(le + 256);
  const int pi = PAIR_I[lane], pj = PAIR_J[lane];
  const bool h5 = (lane & 32) != 0, h4 = (lane & 16) != 0;
  const int ql = (h5 ? 2 : 0) + (h4 ? 1 : 0);
  u32 nw[8];
  {
    const int tok0 = bid * 8 + w;
#pragma unroll
    for (int h = 0; h < 8; h++) nw[h] = (tok0 < TP) ? SEL[((size_t)tok0 * 16 + h * 2) * 16 + (lane & 31)] : 0u;
  }
  for (int tok = bid * 8 + w; tok < TP; tok += nb * 8) {
#pragma unroll
    for (int h = 0; h < 8; h++) selbuf[h * 32 + (lane & 31)] = nw[h];
    {
      const int tokn = tok + nb * 8;
#pragma unroll
      for (int h = 0; h < 8; h++) nw[h] = (tokn < TP) ? SEL[((size_t)tokn * 16 + h * 2) * 16 + (lane & 31)] : 0u;
    }
    for (int h = 0; h < 8; h++) {
      u32 word = lane < 32 ? selbuf[h * 32 + lane] : 0u;
      float val = mono_val(word);
      int idx = word & 127;
      float sa = __shfl(val, pi), sb = __shfl(val, 16 + pj);
      int ia = __shfl(idx, pi), ib = __shfl(idx, 16 + pj);
      float sum = lane < 50 ? sa + sb : -3.0e38f;
      int cnt = 0;
#pragma unroll
      for (int m = 0; m < 50; m++) {
        float sm = __int_as_float(__builtin_amdgcn_readlane(__float_as_int(sum), m));
        cnt += (sm > sum || (sm == sum && m < lane)) ? 1 : 0;
      }
      bool sel = lane < 50 && cnt < 16;
      float mx = wave_max(sum);
      float e = sel ? __expf(sum - mx) : 0.f;
      float tot = wave_sum(e);
      if (sel) { le[h * 16 + cnt] = ia * 128 + ib; lg[h * 16 + cnt] = e / tot; }
    }
    f32x2 hv2[8];
    {
      const u32x4 hw0 = *(const u32x4*)(HN + (size_t)tok * 1024 + lane * 16), hw1 = *(const u32x4*)(HN + (size_t)tok * 1024 + lane * 16 + 8);
#pragma unroll
      for (int c = 0; c < 4; c++) { hv2[c] = f32x2{bflo(hw0[c]), bfhi(hw0[c])}; hv2[4 + c] = f32x2{bflo(hw1[c]), bfhi(hw1[c])}; }
    }
    f32x2 acc2[8];
#pragma unroll
    for (int c = 0; c < 8; c++) acc2[c] = f32x2{0.f, 0.f};
    __builtin_amdgcn_wave_barrier();
    auto gload = [&](PeerGrp& g, int k0) {
#pragma unroll
      for (int q = 0; q < 4; q++) {
        int eid = le[k0 + q];
        g.ua[q] = *(const u32x4*)(U8 + (size_t)eid * 256 + lane * 4);
        g.va[q] = *(const u32x4*)(V8 + (size_t)eid * 256 + lane * 4);
      }
      const int eql = le[k0 + ql];
      g.usl = USC[eql];
      g.vsl = VSC[eql];
    };
    auto compute = [&](const PeerGrp& g, int k0) {
      float d[4];
#pragma unroll
      for (int q = 0; q < 4; q++) {
        f32x2 x = {0.f, 0.f};
#pragma unroll
        for (int c = 0; c < 4; c++) { x += fp8lo(g.ua[q][c]) * hv2[2 * c]; x += fp8hi(g.ua[q][c]) * hv2[2 * c + 1]; }
        d[q] = x[0] + x[1];
      }
      float r0 = (h5 ? d[2] : d[0]) + __shfl_xor(h5 ? d[0] : d[2], 32);
      float r1 = (h5 ? d[3] : d[1]) + __shfl_xor(h5 ? d[1] : d[3], 32);
      float r = (h4 ? r1 : r0) + __shfl_xor(h4 ? r0 : r1, 16);
      r += __shfl_xor(r, 8); r += __shfl_xor(r, 4); r += __shfl_xor(r, 2); r += __shfl_xor(r, 1);
      r *= g.usl;
      float cf = lg[k0 + ql] * 0.5f * r * (1.f + erff(r * 0.7071067811865476f)) * g.vsl;
#pragma unroll
      for (int q = 0; q < 4; q++) {
        float cq = __int_as_float(__builtin_amdgcn_readlane(__float_as_int(cf), ((q >> 1) << 5) | ((q & 1) << 4)));
        f32x2 cv = {cq, cq};
#pragma unroll
        for (int c = 0; c < 4; c++) { acc2[2 * c] += cv * fp8lo(g.va[q][c]); acc2[2 * c + 1] += cv * fp8hi(g.va[q][c]); }
      }
    };
    PeerGrp ga, gb;
    gload(ga, 0);
    for (int k0 = 0; k0 < 128; k0 += 8) {
      gload(gb, k0 + 4);
      compute(ga, k0);
      if (k0 + 8 < 128) gload(ga, k0 + 8);
      compute(gb, k0 + 4);
    }
    __builtin_amdgcn_wave_barrier();
    float* yr = p.out + (size_t)tok * 1024 + lane * 16;
    float4 y0 = *(float4*)(yr), y1 = *(float4*)(yr + 4), y2 = *(float4*)(yr + 8), y3 = *(float4*)(yr + 12);
    y0.x += acc2[0][0]; y0.y += acc2[0][1]; y0.z += acc2[1][0]; y0.w += acc2[1][1];
    y1.x += acc2[2][0]; y1.y += acc2[2][1]; y1.z += acc2[3][0]; y1.w += acc2[3][1];
    y2.x += acc2[4][0]; y2.y += acc2[4][1]; y2.z += acc2[5][0]; y2.w += acc2[5][1];
    y3.x += acc2[6][0]; y3.y += acc2[6][1]; y3.z += acc2[7][0]; y3.w += acc2[7][1];
    if (!DRY || y0.x + y1.y + y2.z == 1.2345e30f) {
      *(float4*)(yr) = y0; *(float4*)(yr + 4) = y1; *(float4*)(yr + 8) = y2; *(float4*)(yr + 12) = y3;
    }
  }

  float* red = (float*)(smem + 16384);
  for (int tok = TP + bid; tok < TT; tok += nb) {
    {
      const int h = 0;
      u32 word = lane < 32 ? SEL[((size_t)tok * 16 + w * 2) * 16 + lane] : 0u;
      float val = mono_val(word);
      int idx = word & 127;
      float sa = __shfl(val, pi), sb = __shfl(val, 16 + pj);
      int ia = __shfl(idx, pi), ib = __shfl(idx, 16 + pj);
      float sum = lane < 50 ? sa + sb : -3.0e38f;
      int cnt = 0;
#pragma unroll
      for (int m = 0; m < 50; m++) {
        float sm = __int_as_float(__builtin_amdgcn_readlane(__float_as_int(sum), m));
        cnt += (sm > sum || (sm == sum && m < lane)) ? 1 : 0;
      }
      bool sel = lane < 50 && cnt < 16;
      float mx = wave_max(sum);
      float e = sel ? __expf(sum - mx) : 0.f;
      float tot = wave_sum(e);
      if (sel) { le[h * 16 + cnt] = ia * 128 + ib; lg[h * 16 + cnt] = e / tot; }
    }
    f32x2 hv2[8];
    {
      const u32x4 hw0 = *(const u32x4*)(HN + (size_t)tok * 1024 + lane * 16), hw1 = *(const u32x4*)(HN + (size_t)tok * 1024 + lane * 16 + 8);
#pragma unroll
      for (int c = 0; c < 4; c++) { hv2[c] = f32x2{bflo(hw0[c]), bfhi(hw0[c])}; hv2[4 + c] = f32x2{bflo(hw1[c]), bfhi(hw1[c])}; }
    }
    f32x2 acc2[8];
#pragma unroll
    for (int c = 0; c < 8; c++) acc2[c] = f32x2{0.f, 0.f};
    __builtin_amdgcn_wave_barrier();
    auto gload = [&](PeerGrp& g, int k0) {
#pragma unroll
      for (int q = 0; q < 4; q++) {
        int eid = le[k0 + q];
        g.ua[q] = *(const u32x4*)(U8 + (size_t)eid * 256 + lane * 4);
        g.va[q] = *(const u32x4*)(V8 + (size_t)eid * 256 + lane * 4);
      }
      const int eql = le[k0 + ql];
      g.usl = USC[eql];
      g.vsl = VSC[eql];
    };
    auto compute = [&](const PeerGrp& g, int k0) {
      float d[4];
#pragma unroll
      for (int q = 0; q < 4; q++) {
        f32x2 x = {0.f, 0.f};
#pragma unroll
        for (int c = 0; c < 4; c++) { x += fp8lo(g.ua[q][c]) * hv2[2 * c]; x += fp8hi(g.ua[q][c]) * hv2[2 * c + 1]; }
        d[q] = x[0] + x[1];
      }
      float r0 = (h5 ? d[2] : d[0]) + __shfl_xor(h5 ? d[0] : d[2], 32);
      float r1 = (h5 ? d[3] : d[1]) + __shfl_xor(h5 ? d[1] : d[3], 32);
      float r = (h4 ? r1 : r0) + __shfl_xor(h4 ? r0 : r1, 16);
      r += __shfl_xor(r, 8); r += __shfl_xor(r, 4); r += __shfl_xor(r, 2); r += __shfl_xor(r, 1);
      r *= g.usl;
      float cf = lg[k0 + ql] * 0.5f * r * (1.f + erff(r * 0.7071067811865476f)) * g.vsl;
#pragma unroll
      for (int q = 0; q < 4; q++) {
        float cq = __int_as_float(__builtin_amdgcn_readlane(__float_as_int(cf), ((q >> 1) << 5) | ((q & 1) << 4)));
        f32x2 cv = {cq, cq};
#pragma unroll
        for (int c = 0; c < 4; c++) { acc2[2 * c] += cv * fp8lo(g.va[q][c]); acc2[2 * c + 1] += cv * fp8hi(g.va[q][c]); }
      }
    };
    PeerGrp ga, gb;
    gload(ga, 0);
    for (int k0 = 0; k0 < 16; k0 += 8) {
      gload(gb, k0 + 4);
      compute(ga, k0);
      if (k0 + 8 < 16) gload(ga, k0 + 8);
      compute(gb, k0 + 4);
    }
#pragma unroll
    for (int c = 0; c < 8; c++) *(f32x2*)(red + w * 1024 + lane * 16 + c * 2) = acc2[c];
    __syncthreads();
    {
      const int c0 = tid * 2;
      float a0 = 0.f, a1 = 0.f;
#pragma unroll
      for (int q = 0; q < 8; q++) { a0 += red[q * 1024 + c0]; a1 += red[q * 1024 + c0 + 1]; }
      float* yr = p.out + (size_t)tok * 1024 + c0;
      float2 yv = *(float2*)yr;
      yv.x += a0; yv.y += a1;
      if (!DRY || yv.x == 1.2345e30f) *(float2*)yr = yv;
    }
    __syncthreads();
  }
}

DI void phase3(const P& p, char* smem, int bid, int nb) {
  for (int id = bid; id < 256; id += nb) { if (id < 128) phase3_prompt(p, smem, id); else phase3_sample(p, smem, id - 128); }
  const int hb = nb > 128 ? bid - 128 : bid, nh = nb > 128 ? nb - 128 : nb;
  if (hb >= 0) {
    const int lane_ = threadIdx.x & 63, w_ = threadIdx.x >> 6;
    conv_fp8_rows(p.peer_u, (u32*)(p.ws + WS_U), (float*)(p.ws + WS_V), hb * 8 + w_, nh * 8, lane_);
    conv_fp8_rows(p.peer_v, (u32*)(p.ws + WS_U + 16777216), (float*)(p.ws + WS_V + 65536), hb * 8 + w_, nh * 8, lane_);
    for (int u = hb * 8 + w_; u < 16 * 8; u += nh * 8) transpose_unit(p.w_out, 1024, (u16*)(p.ws + WS_WOUT), u, lane_);
    for (int u = hb * 8 + w_; u < 32 * 8; u += nh * 8) transpose_unit(p.peer_wq, 2048, (u16*)(p.ws + WS_WQ), u, lane_);
    conv_tab(p.peer_sk, (u16*)(p.ws + WS_SK), (size_t)262144 / 4, (size_t)hb * NT + threadIdx.x, (size_t)nh * NT);
    phase4(p, smem, hb, nh, 0, 8);
  }
}

constexpr int NPHASE = 11;
#ifdef ONLY_PH
#define PHON(n) ((n) == ONLY_PH)
#else
#define PHON(n) true
#endif
__global__ void __launch_bounds__(NT) mega(P p, int lo, int hi) {
  extern __shared__ __attribute__((aligned(16))) char smem[];
  const int bid = blockIdx.x, nb = gridDim.x;
#ifndef DUP_PH
#define DUP_PH -1
#endif
#define RUNPH(n, body)                                   \
  if (DUP_PH == (n) && DUP_PH == 10) { phase10<true>(p, smem, bid, nb); __syncthreads(); } \
  if (PHON(n) && lo <= (n) && (n) < hi) { for (int rep = 0; rep < ((DUP_PH == (n) && DUP_PH != 10) ? hi - 9 : 1); rep++) { body; __syncthreads(); } }         \
  if (lo <= (n) && (n) + 1 < hi) cg::this_grid().sync();
  RUNPH(0, phase0(p, smem, bid, nb))
  RUNPH(1, phase1(p, smem, bid, nb))
  RUNPH(2, phase2(p, smem, bid, nb))
  RUNPH(3, phase3(p, smem, bid, nb))
  RUNPH(4, phase4(p, smem, bid, nb, 8, 16))
  RUNPH(5, phase5(p, smem, bid, nb))
  RUNPH(6, phase6(p, smem, bid, nb))
  RUNPH(7, phase7(p, smem, bid, nb))
  RUNPH(8, phase8(p, bid, nb))
  RUNPH(9, phase9(p, smem, bid, nb))
  RUNPH(10, phase10<false>(p, smem, bid, nb))
}

extern "C" void kernel_launch(void* const* d_in, const int* in_sizes, int n_in, void* d_out, int out_size, void* d_ws,
                              size_t ws_size, hipStream_t stream) {
  static int grid = 0;
  if (grid == 0) {
    int dev = 0, cus = 0, per_cu = 0;
    hipGetDevice(&dev);
    hipDeviceGetAttribute(&cus, hipDeviceAttributeMultiprocessorCount, dev);
    hipFuncSetAttribute((const void*)mega, hipFuncAttributeMaxDynamicSharedMemorySize, LDS_BYTES);
    hipOccupancyMaxActiveBlocksPerMultiprocessor(&per_cu, (const void*)mega, NT, LDS_BYTES);
    if (per_cu < 1) per_cu = 1;
    grid = cus * per_cu;
    if (ws_size < WS_END) { fprintf(stderr, "workspace too small: %zu < %zu\n", ws_size, (size_t)WS_END); }
  }
  P p{};
  const float** pp = (const float**)&p;
  for (int i = 0; i < 25; i++) pp[i] = (const float*)d_in[i];
  p.out = (float*)d_out;
  p.ws = (char*)d_ws;
#ifdef ONE_LAUNCH
  int lo = 0, hi = NPHASE;
  void* args[] = {&p, &lo, &hi};
  hipError_t e = hipLaunchCooperativeKernel((const void*)mega, dim3(grid), dim3(NT), args, LDS_BYTES, stream);
  if (e != hipSuccess) fprintf(stderr, "cooperative launch failed: %s (grid %d)\n", hipGetErrorString(e), grid);
#else
  for (int ph = 0; ph < NPHASE; ph++) hipLaunchKernelGGL(mega, dim3(grid), dim3(NT), LDS_BYTES, stream, p, ph, ph + 1);
#endif
}
```

```cpp
#include <hip/hip_runtime.h>
#include <hip/hip_cooperative_groups.h>
#include <stdint.h>
#include <stdio.h>
namespace cg = cooperative_groups;

#define NT 512
#define ONE_LAUNCH 1
#define DI __device__ __forceinline__
typedef unsigned short u16;
typedef unsigned int u32;
using bf16x8 = __attribute__((ext_vector_type(8))) short;
using f32x4 = __attribute__((ext_vector_type(4))) float;
using f32x16 = __attribute__((ext_vector_type(16))) float;
using u32x4 = __attribute__((ext_vector_type(4))) unsigned;
using u32x2 = __attribute__((ext_vector_type(2))) unsigned;

constexpr int D = 1024, TP = 32768, TS = 256, TT = 33024, SEQ = 16384, INW = 9232;
constexpr int C_Z = 3072, C_BETA = 4096, C_FQ = 4112, C_GA = 7184, C_GB = 8208;
constexpr size_t O_KP = 33816576, O_VP = 67371008, O_SP = 100925440, O_CP = 101187584, O_KS = 101206016,
                 O_VS = 101468160, O_SS = 101730304, O_CS = 103827456;
constexpr size_t WS_WIN = 0, WS_WOUT = 18907136, WS_WQ = 21004288, WS_SK = 25198592, WS_U = 25722880, WS_V = 59277312,
                 WS_BIG = 92831744, WS_OA = 295731200, WS_OB = 363364352, WS_BETA = 430997504, WS_G = 432054272,
                 WS_SSQ = 433111040, WS_SEL = 441565184, WS_GL = 475381760, WS_END = 475398144;
constexpr size_t BIG_KN = 67633152, BIG_VT = 135266304;
constexpr int LDS_BYTES = 163840;
constexpr float RMS_EPS = 1e-6f;
constexpr float LOG2E = 1.4426950408889634f;
constexpr float QSCALE = LOG2E * 0.125f;
constexpr float LAM_INIT = 0.2f;

struct P {
  const float *x_prompt, *x_sample, *cache_k, *cache_v, *state_s, *state_conv, *norm_mix_g, *w_in, *conv_w, *a_log,
      *dt_bias, *delta_norm_g, *qn_g, *kn_g, *lq1, *lk1, *lq2, *lk2, *diff_norm_g, *w_out, *norm_ffn_g, *peer_wq,
      *peer_sk, *peer_u, *peer_v;
  float* out;
  char* ws;
};

typedef float f32x2 __attribute__((ext_vector_type(2)));
typedef __bf16 bfx2 __attribute__((ext_vector_type(2)));
DI u32 pack2(float a, float b) { f32x2 v = {a, b}; bfx2 r = __builtin_convertvector(v, bfx2); return __builtin_bit_cast(u32, r); }
DI u16 f2bf(float x) { return (u16)(pack2(x, x) & 0xffffu); }
DI float bf2f(u16 b) { return __uint_as_float(((u32)b) << 16); }
DI float bflo(u32 w) { return __uint_as_float(w << 16); }
DI float bfhi(u32 w) { return __uint_as_float(w & 0xffff0000u); }
DI float wave_sum(float v) { for (int m = 32; m >= 1; m >>= 1) v += __shfl_xor(v, m); return v; }
DI float wave_max(float v) { for (int m = 32; m >= 1; m >>= 1) v = fmaxf(v, __shfl_xor(v, m)); return v; }
#define DPP_ADD(v, ctrl) ((v) + __int_as_float(__builtin_amdgcn_update_dpp(0, __float_as_int(v), (ctrl), 0xF, 0xF, true)))
DI float row16_sum(float v) { v = DPP_ADD(v, 0xB1); v = DPP_ADD(v, 0x4E); v = DPP_ADD(v, 0x124); v = DPP_ADD(v, 0x128); return v; }
DI float sigmoidf_(float x) { return 1.f / (1.f + __expf(-x)); }
DI f32x4 mfma16(bf16x8 a, bf16x8 b, f32x4 c) { return __builtin_amdgcn_mfma_f32_16x16x32_bf16(a, b, c, 0, 0, 0); }
DI f32x16 mfma32(bf16x8 a, bf16x8 b, f32x16 c) { return __builtin_amdgcn_mfma_f32_32x32x16_bf16(a, b, c, 0, 0, 0); }
DI bf16x8 ldfrag(const u16* p) { return *(const bf16x8*)p; }
#define VPERM(a) ((((a) & 1) << 1) | ((a) >> 1))

#define RAW_BARRIER() do { asm volatile("s_waitcnt lgkmcnt(0)" ::: "memory"); __builtin_amdgcn_s_barrier(); } while (0)
template <int N> DI void wait_vmcnt() { asm volatile("s_waitcnt vmcnt(%0)" ::"n"(N) : "memory"); }

template <int BN, bool MERGE, bool SWAP, int NJ, class BRow, int TM = 4>
DI void gemm_main(const u16* __restrict__ A, int m0, BRow brow, char* smem, f32x4 (&acc)[TM][NJ]) {
  constexpr int BM = TM * 64;
  constexpr int NIA = BM / 64, NIB = BN / 64;
  constexpr int NI = NIA + NIB;
  constexpr int STAGE = (BM + BN) * 128;
  constexpr int NST = (3 * STAGE <= LDS_BYTES) ? 3 : 2;
  const int tid = threadIdx.x, lane = tid & 63, w = __builtin_amdgcn_readfirstlane(tid >> 6), wm = w >> 1, wn = w & 1;
#pragma unroll
  for (int i = 0; i < TM; i++)
#pragma unroll
    for (int j = 0; j < NJ; j++) acc[i][j] = f32x4{0.f, 0.f, 0.f, 0.f};
  const u16* ga[NIA];
  const u16* gb[NIB];
#pragma unroll
  for (int ii = 0; ii < NIA; ii++) {
    int r = (w * NIA + ii) * 8 + (lane >> 3), c = (lane & 7) ^ ((r >> 1) & 7);
    ga[ii] = A + (size_t)(m0 + r) * 1024 + c * 8;
  }
#pragma unroll
  for (int ii = 0; ii < NIB; ii++) {
    int r = (w * NIB + ii) * 8 + (lane >> 3), c = (lane & 7) ^ ((r >> 1) & 7);
    gb[ii] = brow(r) + c * 8;
  }
  auto glds = [&](int kt, int st) {
    char* da = smem + st * STAGE + w * (NIA * 1024);
    char* db = smem + st * STAGE + BM * 128 + w * (NIB * 1024);
#pragma unroll
    for (int ii = 0; ii < NIA; ii++) __builtin_amdgcn_global_load_lds((const unsigned*)(ga[ii] + kt * 64), (unsigned*)(da + ii * 1024), 16, 0, 0);
#pragma unroll
    for (int ii = 0; ii < NIB; ii++) __builtin_amdgcn_global_load_lds((const unsigned*)(gb[ii] + kt * 64), (unsigned*)(db + ii * 1024), 16, 0, 0);
  };
  const int l15 = lane & 15, l4 = lane >> 4;
  const int swz = (l15 >> 1) & 7;
  __syncthreads();
  wait_vmcnt<0>();
  glds(0, 0);
  if (NST == 3) glds(1, 1);
  for (int kt = 0; kt < 16; kt++) {
    if (NST == 3) { if (kt + 1 < 16) wait_vmcnt<NI>(); else wait_vmcnt<0>(); }
    else wait_vmcnt<0>();
    RAW_BARRIER();
    if (NST == 3) { if (kt + 2 < 16) glds(kt + 2, (kt + 2) % 3); }
    else { if (kt + 1 < 16) glds(kt + 1, (kt + 1) & 1); }
    const char* As = smem + (NST == 3 ? kt % 3 : kt & 1) * STAGE;
    const char* Bs = As + BM * 128;
    bf16x8 af[2][TM], bfr[2][NJ];
#pragma unroll
    for (int kk = 0; kk < 2; kk++) {
      const int coff = ((kk * 4 + l4) ^ swz) << 4;
#pragma unroll
      for (int i = 0; i < TM; i++) af[kk][i] = *(const bf16x8*)(As + (wm * (TM * 16) + i * 16 + l15) * 128 + coff);
#pragma unroll
      for (int j = 0; j < NJ; j++) {
        int nrow = MERGE ? ((j >> 1) * 64 + wn * 32 + (j & 1) * 16) : (wn * 64 + j * 16);
        bfr[kk][j] = *(const bf16x8*)(Bs + (nrow + l15) * 128 + coff);
      }
      __builtin_amdgcn_sched_barrier(0);
    }
#pragma unroll
    for (int kk = 0; kk < 2; kk++) {
#pragma unroll
      for (int i = 0; i < TM; i++)
#pragma unroll
        for (int j = 0; j < NJ; j++) acc[i][j] = SWAP ? mfma16(bfr[kk][j], af[kk][i], acc[i][j]) : mfma16(af[kk][i], bfr[kk][j], acc[i][j]);
      __builtin_amdgcn_sched_barrier(0);
    }
  }
  __syncthreads();
}

DI void transpose_unit(const float* __restrict__ W, int N, u16* __restrict__ WT, int unit, int lane) {
  int nblk = unit >> 3, kblk = unit & 7;
  int n = nblk * 64 + lane, k0 = kblk * 128;
  if (n < N) {
    for (int kk = 0; kk < 128; kk += 8) {
      float v[8];
#pragma unroll
      for (int i = 0; i < 8; i++) v[i] = W[(size_t)(k0 + kk + i) * N + n];
      u32x4 o = {pack2(v[0], v[1]), pack2(v[2], v[3]), pack2(v[4], v[5]), pack2(v[6], v[7])};
      *(u32x4*)(WT + (size_t)n * 1024 + k0 + kk) = o;
    }
  }
}

DI void conv_tab(const float* __restrict__ src, u16* __restrict__ dst, size_t n4, size_t gtid, size_t gstride) {
  for (size_t i = gtid; i < n4; i += gstride) {
    float4 v = ((const float4*)src)[i];
    u32x2 o = {pack2(v.x, v.y), pack2(v.z, v.w)};
    ((u32x2*)dst)[i] = o;
  }
}

DI void phase0(const P& p, char* smem, int bid, int nb) {
  const int tid = threadIdx.x, lane = tid & 63, w = tid >> 6;
  u16* XN = (u16*)p.out;
  float* BETA = (float*)(p.ws + WS_BETA);
  float* G = (float*)(p.ws + WS_G);
  float* Wt = (float*)smem;
  for (int i = tid; i < 4096; i += NT) {
    int k = i >> 2, q = i & 3;
    float4 wv = *(const float4*)(p.w_in + (size_t)k * INW + C_BETA + q * 4);
    Wt[(q * 4 + 0) * 1024 + k] = wv.x; Wt[(q * 4 + 1) * 1024 + k] = wv.y; Wt[(q * 4 + 2) * 1024 + k] = wv.z; Wt[(q * 4 + 3) * 1024 + k] = wv.w;
  }
  __syncthreads();
#pragma unroll 2
  for (int row = bid * 8 + w; row < TT; row += nb * 8) {
    const float* xr = row < TP ? p.x_prompt + (size_t)row * D : p.x_sample + (size_t)(row - TP) * D;
    float xn[16];
    float ss = 0.f;
#pragma unroll
    for (int i = 0; i < 4; i++) {
      float4 v = *(const float4*)(xr + i * 256 + lane * 4);
      xn[4 * i] = v.x; xn[4 * i + 1] = v.y; xn[4 * i + 2] = v.z; xn[4 * i + 3] = v.w;
      ss += v.x * v.x + v.y * v.y + v.z * v.z + v.w * v.w;
    }
    ss = wave_sum(ss);
    float rinv = rsqrtf(ss * (1.f / 1024.f) + RMS_EPS);
#pragma unroll
    for (int i = 0; i < 4; i++) {
      float4 g4 = *(const float4*)(p.norm_mix_g + i * 256 + lane * 4);
      xn[4 * i] *= rinv * g4.x; xn[4 * i + 1] *= rinv * g4.y; xn[4 * i + 2] *= rinv * g4.z; xn[4 * i + 3] *= rinv * g4.w;
      u32x2 o = {pack2(xn[4 * i], xn[4 * i + 1]), pack2(xn[4 * i + 2], xn[4 * i + 3])};
      *(u32x2*)(XN + (size_t)row * 1024 + i * 256 + lane * 4) = o;
    }
    float v = 0.f;
#pragma nounroll
    for (int jg = 0; jg < 4; jg++) {
      float d4[4] = {0.f, 0.f, 0.f, 0.f};
#pragma unroll
      for (int q = 0; q < 4; q++)
#pragma unroll
        for (int i = 0; i < 4; i++) {
          float4 wv = *(const float4*)(Wt + (jg * 4 + q) * 1024 + i * 256 + lane * 4);
          d4[q] += xn[4 * i] * wv.x + xn[4 * i + 1] * wv.y + xn[4 * i + 2] * wv.z + xn[4 * i + 3] * wv.w;
        }
#pragma unroll
      for (int q = 0; q < 4; q++) { float r = wave_sum(d4[q]); v = (lane == jg * 4 + q) ? r : v; }
    }
    if (lane < 8) BETA[row * 8 + lane] = sigmoidf_(v);
    else if (lane < 16) {
      int hh = lane - 8;
      float xx = v + p.dt_bias[hh];
      float sp = xx > 20.f ? xx : log1pf(expf(xx));
      G[row * 8 + hh] = -expf(p.a_log[hh]) * sp;
    }
  }
  {
    const int gw = bid * 8 + w, gws = nb * 8;
    for (int u = gw; u < 145 * 8; u += gws) transpose_unit(p.w_in, INW, (u16*)(p.ws + WS_WIN), u, lane);
  }
}

template <int TM>
DI void phase1_tile(const P& p, char* smem, int m0, int n0) {
  const u16* XN = (const u16*)p.out;
  const u16* WT = (const u16*)(p.ws + WS_WIN);
  u16* QKV = (u16*)(p.ws + WS_BIG);
  const int lane = threadIdx.x & 63, w = __builtin_amdgcn_readfirstlane(threadIdx.x >> 6), wm = w >> 1, wn = w & 1;
  f32x4 acc[TM][4];
  auto brow = [&](int r) { return WT + (size_t)(n0 + r) * 1024; };
  gemm_main<128, false, true, 4, decltype(brow), TM>(XN, m0, brow, smem, acc);
#pragma unroll
  for (int i = 0; i < TM; i++) {
    int tok = m0 + wm * (TM * 16) + i * 16 + (lane & 15);
    float* cdst = nullptr;
    if (tok < TP) { int b = tok >> 14, tt = tok & 16383; if (tt >= 16381) cdst = p.out + O_CP + (size_t)(b * 3 + tt - 16381) * 3072; }
    else { int s = (tok - TP) >> 4, tt = tok & 15; if (tt >= 13) cdst = p.out + O_CS + (size_t)(s * 3 + tt - 13) * 3072; }
#pragma unroll
    for (int j = 0; j < 4; j++) {
      int n = n0 + wn * 64 + j * 16 + 4 * (lane >> 4);
      f32x4 a = acc[i][j];
      u32x2 o = {pack2(a[0], a[1]), pack2(a[2], a[3])};
      *(u32x2*)(QKV + (size_t)tok * 3072 + n) = o;
      if (cdst) *(float4*)(cdst + n) = make_float4(a[0], a[1], a[2], a[3]);
    }
  }
}
DI void phase1(const P& p, char* smem, int bid, int nb) {
  for (int t = bid; t < 128 * 24; t += nb) phase1_tile<4>(p, smem, (t / 24) * 256, (t % 24) * 128);
  for (int t = bid; t < 4 * 24; t += nb) phase1_tile<1>(p, smem, TP + (t / 24) * 64, (t % 24) * 128);
}

DI void phase2(const P& p, char* smem, int bid, int nb) {
  const int tid = threadIdx.x, lane = tid & 63, w = __builtin_amdgcn_readfirstlane(tid >> 6);
  const u16* QKV = (const u16*)(p.ws + WS_BIG);
  const float* BETA = (const float*)(p.ws + WS_BETA);
  const float* G = (const float*)(p.ws + WS_G);
  float* GL = (float*)(p.ws + WS_GL);
  u16* NEGWU = (u16*)(p.out + O_KP);
  u16* KDQG = (u16*)(p.out + O_VP);
  u16* INTRA = (u16*)((char*)p.out + 67633152);
  u16* Kb = (u16*)smem;
  u16* Qb = Kb + 64 * 136;
  float* Lf = (float*)(Qb + 64 * 136);
  float* Tf = Lf + 64 * 65;
  u16* Tb = (u16*)(Tf + 64 * 65);
  u16* KBGt = Tb + 64 * 72;
  u16* VBt = KBGt + 128 * 72;
  float* Ys = (float*)(VBt + 128 * 72);
  float* gc = Ys + 16 * 17;
  float* bt = gc + 64;

  for (int item = bid; item < 4096; item += nb) {
    const int h = item & 7, n = (item >> 3) & 255, b = item >> 11;
    const int tok0 = b * SEQ + n * 64;
    const int sidx = (b * 8 + h) * 256 + n;
    const int r = tid >> 3, seg = tid & 7;
    __syncthreads();
    if (tid < 64) {
      float g = G[(tok0 + tid) * 8 + h];
      for (int off = 1; off < 64; off <<= 1) { float o = __shfl_up(g, off); if (lane >= off) g += o; }
      gc[tid] = g;
      bt[tid] = BETA[(tok0 + tid) * 8 + h];
      if (tid == 63) GL[(b * 8 + h) * 256 + n] = __expf(g);
    }
    float qv[16], kv[16], vv[16];
#pragma unroll
    for (int mat = 0; mat < 3; mat++) {
      float val[16];
#pragma unroll
      for (int c = 0; c < 16; c++) val[c] = 0.f;
      const int col = mat * 1024 + h * 128 + seg * 16;
#pragma unroll
      for (int j = 0; j < 4; j++) {
        int tl = n * 64 + r - 3 + j;
        if (tl >= 0) {
          const u16* src = QKV + (size_t)(tok0 + r - 3 + j) * 3072 + col;
          u32x4 r0 = *(const u32x4*)src, r1 = *(const u32x4*)(src + 8);
          const float4* cw = (const float4*)(p.conv_w + j * 3072 + col);
          float4 c0 = cw[0], c1 = cw[1], c2 = cw[2], c3 = cw[3];
          val[0] += c0.x * bflo(r0[0]); val[1] += c0.y * bfhi(r0[0]); val[2] += c0.z * bflo(r0[1]); val[3] += c0.w * bfhi(r0[1]);
          val[4] += c1.x * bflo(r0[2]); val[5] += c1.y * bfhi(r0[2]); val[6] += c1.z * bflo(r0[3]); val[7] += c1.w * bfhi(r0[3]);
          val[8] += c2.x * bflo(r1[0]); val[9] += c2.y * bfhi(r1[0]); val[10] += c2.z * bflo(r1[1]); val[11] += c2.w * bfhi(r1[1]);
          val[12] += c3.x * bflo(r1[2]); val[13] += c3.y * bfhi(r1[2]); val[14] += c3.z * bflo(r1[3]); val[15] += c3.w * bfhi(r1[3]);
        }
      }
      float ss = 0.f;
#pragma unroll
      for (int c = 0; c < 16; c++) { float x = val[c]; x = x / (1.f + __expf(-x)); val[c] = x; ss += x * x; }
      if (mat < 2) {
        ss += __shfl_xor(ss, 1); ss += __shfl_xor(ss, 2); ss += __shfl_xor(ss, 4);
        float rinv = rsqrtf(ss + RMS_EPS) * (mat == 0 ? 0.08838834764831845f : 1.f);
#pragma unroll
        for (int c = 0; c < 16; c++) val[c] *= rinv;
      }
#pragma unroll
      for (int c = 0; c < 16; c++) { if (mat == 0) qv[c] = val[c]; else if (mat == 1) kv[c] = val[c]; else vv[c] = val[c]; }
    }
    __syncthreads();
    const float gr = gc[r], br = bt[r], glast = gc[63];
    const float eg = __expf(gr), ekd = __expf(glast - gr);
    u16* qg_out = KDQG + (size_t)sidx * 16384 + 8192;
    u16* kdT_out = KDQG + (size_t)sidx * 16384;
    {
      u32x4 o0, o1, k0, k1, q0, q1;
#pragma unroll
      for (int c = 0; c < 4; c++) {
        o0[c] = pack2(qv[2 * c] * eg, qv[2 * c + 1] * eg); o1[c] = pack2(qv[8 + 2 * c] * eg, qv[9 + 2 * c] * eg);
        k0[c] = pack2(kv[2 * c], kv[2 * c + 1]); k1[c] = pack2(kv[8 + 2 * c], kv[9 + 2 * c]);
        q0[c] = pack2(qv[2 * c], qv[2 * c + 1]); q1[c] = pack2(qv[8 + 2 * c], qv[9 + 2 * c]);
      }
      *(u32x4*)(qg_out + r * 128 + seg * 16) = o0; *(u32x4*)(qg_out + r * 128 + seg * 16 + 8) = o1;
      *(u32x4*)(Kb + r * 136 + seg * 16) = k0; *(u32x4*)(Kb + r * 136 + seg * 16 + 8) = k1;
      *(u32x4*)(Qb + r * 136 + seg * 16) = q0; *(u32x4*)(Qb + r * 136 + seg * 16 + 8) = q1;
    }
    {
      const int ob = seg * 16 * 72 + (((r >> 3) ^ seg) << 3) + (r & 7);
      const int og = seg * 16 * 64 + r;
      const float sk = br * eg;
#pragma unroll
      for (int c = 0; c < 16; c++) {
        kdT_out[og + c * 64] = f2bf(kv[c] * ekd);
        KBGt[ob + c * 72] = f2bf(kv[c] * sk);
        VBt[ob + c * 72] = f2bf(vv[c] * br);
      }
    }
    for (int i = tid; i < 64 * 65; i += NT) Tf[i] = 0.f;
    __syncthreads();
    if (w < 4) {
      const int ti = w;
      f32x4 c4[4];
#pragma unroll
      for (int tj = 0; tj < 4; tj++) c4[tj] = f32x4{0.f, 0.f, 0.f, 0.f};
#pragma unroll
      for (int kk = 0; kk < 4; kk++) {
        bf16x8 a = ldfrag(Kb + (ti * 16 + (lane & 15)) * 136 + kk * 32 + (lane >> 4) * 8);
#pragma unroll
        for (int tj = 0; tj < 4; tj++) {
          bf16x8 bb = ldfrag(Kb + (tj * 16 + (lane & 15)) * 136 + kk * 32 + (lane >> 4) * 8);
          c4[tj] = mfma16(a, bb, c4[tj]);
        }
      }
#pragma unroll
      for (int tj = 0; tj < 4; tj++) {
        int j = tj * 16 + (lane & 15);
        float gj = gc[j];
#pragma unroll
        for (int rr = 0; rr < 4; rr++) {
          int i = ti * 16 + 4 * (lane >> 4) + rr;
          float v = (j < i) ? bt[i] * c4[tj][rr] * __expf(gc[i] - gj) : 0.f;
          Lf[i * 65 + j] = v;
        }
      }
    } else {
      const int ti = w - 4;
      f32x4 c4[4];
#pragma unroll
      for (int tj = 0; tj < 4; tj++) c4[tj] = f32x4{0.f, 0.f, 0.f, 0.f};
#pragma unroll
      for (int kk = 0; kk < 4; kk++) {
        bf16x8 bq = ldfrag(Qb + (ti * 16 + (lane & 15)) * 136 + kk * 32 + (lane >> 4) * 8);
#pragma unroll
        for (int tj = 0; tj < 4; tj++) {
          bf16x8 ak = ldfrag(Kb + (tj * 16 + (lane & 15)) * 136 + kk * 32 + (lane >> 4) * 8);
          c4[tj] = mfma16(ak, bq, c4[tj]);
        }
      }
      const int i = ti * 16 + (lane & 15);
      const float gi = gc[i];
      u16* intra_out = INTRA + (size_t)sidx * 4096;
#pragma unroll
      for (int tj = 0; tj < 4; tj++) {
        float o[4];
#pragma unroll
        for (int rr = 0; rr < 4; rr++) {
          int j = tj * 16 + 4 * (lane >> 4) + rr;
          o[rr] = (j <= i) ? c4[tj][rr] * __expf(gi - gc[j]) : 0.f;
        }
        u32x2 ov = {pack2(o[0], o[1]), pack2(o[2], o[3])};
        *(u32x2*)(intra_out + i * 64 + tj * 16 + 4 * (lane >> 4)) = ov;
      }
    }
    __syncthreads();
    if (tid < 64) {
      const int blk = tid >> 4, c = tid & 15;
      float x[16];
#pragma unroll
      for (int i = 0; i < 16; i++) {
        float s = (i == c) ? 1.f : 0.f;
#pragma unroll
        for (int j = 0; j < i; j++) s -= Lf[(blk * 16 + i) * 65 + blk * 16 + j] * x[j];
        x[i] = s;
      }
#pragma unroll
      for (int i = 0; i < 16; i++) Tf[(blk * 16 + i) * 65 + blk * 16 + c] = x[i];
    }
    __syncthreads();
    for (int dl = 1; dl < 4; dl++) {
      for (int bi = dl; bi < 4; bi++) {
        const int bj = bi - dl;
        const int rr = (tid >> 4) & 15, c = tid & 15;
        if (tid < 256) {
          float y = 0.f;
          for (int kk = bj * 16; kk < bi * 16; kk++) y += Lf[(bi * 16 + rr) * 65 + kk] * Tf[kk * 65 + bj * 16 + c];
          Ys[rr * 17 + c] = y;
        }
        __syncthreads();
        if (tid < 256) {
          float t = 0.f;
#pragma unroll
          for (int m = 0; m < 16; m++) t -= Tf[(bi * 16 + rr) * 65 + bi * 16 + m] * Ys[m * 17 + c];
          Tf[(bi * 16 + rr) * 65 + bj * 16 + c] = t;
        }
        __syncthreads();
      }
    }
    for (int i = tid; i < 4096; i += NT) { int ri = i >> 6, ci = i & 63; Tb[ri * 72 + ci] = f2bf(Tf[ri * 65 + ci]); }
    __syncthreads();
    {
      const bool isU = w >= 4;
      const int wq = w & 3;
      const u16* Xt = isU ? VBt : KBGt;
      u16* dst = NEGWU + (size_t)sidx * 16384 + (isU ? 8192 : 0);
#pragma unroll
      for (int tdl = 0; tdl < 2; tdl++) {
        const int td = wq * 2 + tdl;
        f32x4 c4[4];
#pragma unroll
        for (int ti = 0; ti < 4; ti++) c4[ti] = f32x4{0.f, 0.f, 0.f, 0.f};
#pragma unroll
        for (int kk = 0; kk < 2; kk++) {
          bf16x8 a = ldfrag(Xt + (td * 16 + (lane & 15)) * 72 + (((kk * 4 + (lane >> 4)) ^ td) << 3));
#pragma unroll
          for (int ti = 0; ti < 4; ti++) {
            bf16x8 bb = ldfrag(Tb + (ti * 16 + (lane & 15)) * 72 + kk * 32 + (lane >> 4) * 8);
            c4[ti] = isU ? mfma16(bb, a, c4[ti]) : mfma16(a, bb, c4[ti]);
          }
        }
        if (!isU) {
#pragma unroll
          for (int ti = 0; ti < 4; ti++) {
            int i = ti * 16 + (lane & 15), d = td * 16 + 4 * (lane >> 4);
            u32x2 ov = {pack2(-c4[ti][0], -c4[ti][1]), pack2(-c4[ti][2], -c4[ti][3])};
            *(u32x2*)(dst + i * 128 + d) = ov;
          }
        } else {
#pragma unroll
          for (int ti = 0; ti < 4; ti++) {
            int i = ti * 16 + 4 * (lane >> 4), d = td * 16 + (lane & 15);
            u32x2 ov = {pack2(c4[ti][0], c4[ti][1]), pack2(c4[ti][2], c4[ti][3])};
            *(u32x2*)(dst + d * 64 + i) = ov;
          }
        }
      }
    }
  }
}

struct ScanOps { bf16x8 a[4]; bf16x8 b[4]; bf16x8 ub; };

DI void scan_load(ScanOps& o, const u16* NEGWU, const u16* KDQG, const u16* INTRA, const float* GL, int item, int w, int lane, int e0) {
  const bool sw = w < 4;
  const int wq = w & 3;
  const u16* pa = sw ? NEGWU + (size_t)item * 16384 : KDQG + (size_t)item * 16384 + 8192;
  const u16* pb = sw ? KDQG + (size_t)item * 16384 : INTRA + (size_t)item * 4096;
  const int rowb = sw ? 32 * wq : 16 * wq, dstep = sw ? 16 : 0;
#pragma unroll
  for (int kk = 0; kk < 4; kk++) o.a[kk] = ldfrag(pa + (16 * wq + (lane & 15)) * 128 + kk * 32 + (lane >> 4) * 8);
#pragma unroll
  for (int dt = 0; dt < 2; dt++)
#pragma unroll
    for (int kk = 0; kk < 2; kk++) o.b[dt * 2 + kk] = ldfrag(pb + (rowb + dt * dstep + (lane & 15)) * 64 + kk * 32 + (lane >> 4) * 8);
  o.ub = ldfrag(NEGWU + (size_t)item * 16384 + 8192 + (e0 + (lane & 15)) * 64 + 16 * wq + 8 * ((lane >> 4) & 1));
}

DI void phase3_prompt(const P& p, char* smem, int id) {
  const int tid = threadIdx.x, lane = tid & 63, w = __builtin_amdgcn_readfirstlane(tid >> 6);
  const int x = id & 7, sl = (id >> 3) & 7, hi = id >> 6;
  const int bh = hi * 8 + x, b = bh >> 3, h = bh & 7, e0 = sl * 16;
  const u16* NEGWU = (const u16*)(p.out + O_KP);
  const u16* KDQG = (const u16*)(p.out + O_VP);
  const u16* INTRA = (const u16*)((const char*)p.out + 67633152);
  const float* GL = (const float*)(p.ws + WS_GL);
  u16* OA = (u16*)(p.ws + WS_OA);
  float* SSQ = (float*)(p.ws + WS_SSQ);
  u16* Sl = (u16*)smem;
  u16* Vn = Sl + 16 * 136;
  float* dec = (float*)(Vn + 16 * 72);
  u16* Os = (u16*)(dec + 256);
  __syncthreads();
  for (int i = tid; i < 16 * 136; i += NT) Sl[i] = 0;
  if (tid < 256) dec[tid] = GL[(b * 8 + h) * 256 + tid];
  f32x4 Sreg[2] = {f32x4{0.f, 0.f, 0.f, 0.f}, f32x4{0.f, 0.f, 0.f, 0.f}};
  bf16x8 identA;
#pragma unroll
  for (int j = 0; j < 8; j++) identA[j] = ((lane >> 4) < 2 && 8 * (lane >> 4) + j == (lane & 15)) ? (short)0x3F80 : (short)0;
  constexpr int NS = 4;
  ScanOps st[NS];
  __syncthreads();
  constexpr int GS = 8;
  for (int n0 = 0; n0 < 256; n0 += GS) {
#pragma unroll
    for (int j = 0; j < NS - 1; j++) scan_load(st[j], NEGWU, KDQG, INTRA, GL, (b * 8 + h) * 256 + n0 + j, w, lane, e0);
#pragma unroll
    for (int j = 0; j < GS; j++) {
      const int n = n0 + j;
      __builtin_amdgcn_sched_barrier(0);
      if (j + NS - 1 < GS) scan_load(st[(j + NS - 1) % NS], NEGWU, KDQG, INTRA, GL, (b * 8 + h) * 256 + n + NS - 1, w, lane, e0);
      __builtin_amdgcn_sched_barrier(0);
      const ScanOps& cur = st[j % NS];
      bf16x8 sf[4];
#pragma unroll
      for (int kk = 0; kk < 4; kk++) sf[kk] = ldfrag(Sl + (lane & 15) * 136 + kk * 32 + (lane >> 4) * 8);
      f32x4 acc = f32x4{0.f, 0.f, 0.f, 0.f};
      if (w < 4) acc = mfma16(identA, cur.ub, acc);
#pragma unroll
      for (int kk = 0; kk < 4; kk++) acc = mfma16(cur.a[kk], sf[kk], acc);
      if (w < 4) {
        u32x2 ov = {pack2(acc[0], acc[1]), pack2(acc[2], acc[3])};
        *(u32x2*)(Vn + (lane & 15) * 72 + 16 * w + 4 * (lane >> 4)) = ov;
      }
      __syncthreads();
      bf16x8 vf[2];
#pragma unroll
      for (int kk = 0; kk < 2; kk++) vf[kk] = ldfrag(Vn + (lane & 15) * 72 + kk * 32 + (lane >> 4) * 8);
      if (w < 4) {
#pragma unroll
        for (int dt = 0; dt < 2; dt++) {
          f32x4 sv = Sreg[dt];
          const float dcy = dec[n];
          sv[0] *= dcy; sv[1] *= dcy; sv[2] *= dcy; sv[3] *= dcy;
#pragma unroll
          for (int kk = 0; kk < 2; kk++) sv = mfma16(cur.b[dt * 2 + kk], vf[kk], sv);
          Sreg[dt] = sv;
          u32x2 ov = {pack2(sv[0], sv[1]), pack2(sv[2], sv[3])};
          *(u32x2*)(Sl + (lane & 15) * 136 + 32 * w + dt * 16 + 4 * (lane >> 4)) = ov;
        }
      } else {
#pragma unroll
        for (int kk = 0; kk < 2; kk++) acc = mfma16(cur.b[kk], vf[kk], acc);
        const int wq = w - 4;
#pragma unroll
        for (int rr = 0; rr < 4; rr++) Os[(16 * wq + 4 * (lane >> 4) + rr) * 16 + (lane & 15)] = f2bf(acc[rr]);
      }
      __syncthreads();
      {
        const u32 ov = ((const u32*)Os)[tid];
        const int row = tid >> 3, cp = tid & 7;
        const size_t tk = (size_t)(b * SEQ + n * 64 + row);
        *(u32*)(OA + tk * 1024 + h * 128 + e0 + cp * 2) = ov;
        float s2 = bflo(ov) * bflo(ov) + bfhi(ov) * bfhi(ov);
        s2 = DPP_ADD(s2, 0xB1); s2 = DPP_ADD(s2, 0x4E); s2 = DPP_ADD(s2, 0x124);
        if (cp == 4) SSQ[tk * 64 + h * 8 + sl] = s2;
      }
    }
  }
  if (w < 4) {
#pragma unroll
    for (int dt = 0; dt < 2; dt++)
#pragma unroll
      for (int rr = 0; rr < 4; rr++) {
        int d = 32 * w + dt * 16 + 4 * (lane >> 4) + rr;
        p.out[O_SP + ((size_t)(b * 8 + h) * 128 + d) * 128 + e0 + (lane & 15)] = Sreg[dt][rr];
      }
  }
}

DI void phase3_sample(const P& p, char* smem, int id) {
  const int tid = threadIdx.x, lane = tid & 63, w = tid >> 6;
  const int s = id >> 3, h = id & 7;
  const u16* QKV = (const u16*)(p.ws + WS_BIG);
  const float* BETA = (const float*)(p.ws + WS_BETA);
  const float* G = (const float*)(p.ws + WS_G);
  u16* OA = (u16*)(p.ws + WS_OA);
  float* SSQ = (float*)(p.ws + WS_SSQ);
  float* qkvs = (float*)smem;
  float* red = qkvs + 16 * 384;
  float* red2 = red + 512;
  float* osq = red2 + 512;
  __syncthreads();
  for (int idx = tid; idx < 16 * 384; idx += NT) {
    int t = idx / 384, c = idx % 384, mat = c >> 7, cc = c & 127, col = mat * 1024 + h * 128 + cc;
    float v = 0.f;
#pragma unroll
    for (int j = 0; j < 4; j++) {
      int tt = t - 3 + j;
      float e = tt < 0 ? p.state_conv[((size_t)s * 3 + (3 + tt)) * 3072 + col] : bf2f(QKV[(size_t)(TP + s * 16 + tt) * 3072 + col]);
      v += p.conv_w[j * 3072 + col] * e;
    }
    v = v / (1.f + __expf(-v));
    qkvs[t * 384 + c] = v;
  }
  __syncthreads();
  for (int i = 0; i < 4; i++) {
    int rr = w * 4 + i, t = rr >> 1, mat = rr & 1;
    float a0 = qkvs[t * 384 + mat * 128 + lane], a1 = qkvs[t * 384 + mat * 128 + 64 + lane];
    float ss = wave_sum(a0 * a0 + a1 * a1);
    float rinv = rsqrtf(ss + RMS_EPS) * (mat == 0 ? 0.08838834764831845f : 1.f);
    qkvs[t * 384 + mat * 128 + lane] = a0 * rinv;
    qkvs[t * 384 + mat * 128 + 64 + lane] = a1 * rinv;
  }
  __syncthreads();
  const int e = tid & 127, dq = tid >> 7;
  float S[32];
  const float* s0 = p.state_s + ((size_t)(s * 8 + h) * 128 + dq * 32) * 128 + e;
#pragma unroll
  for (int i = 0; i < 32; i++) S[i] = s0[(size_t)i * 128];
  for (int t = 0; t < 16; t++) {
    const int tok = TP + s * 16 + t;
    const float a = __expf(G[tok * 8 + h]), bb = BETA[tok * 8 + h];
    const float* qt = qkvs + t * 384;
    const float* kt = qt + 128;
    const float* vt = qt + 256;
    float r = 0.f;
#pragma unroll
    for (int i = 0; i < 32; i++) r += kt[dq * 32 + i] * S[i];
    red[dq * 128 + e] = r;
    __syncthreads();
    r = red[e] + red[128 + e] + red[256 + e] + red[384 + e];
    const float coef = bb * (vt[e] - a * r);
    float o = 0.f;
#pragma unroll
    for (int i = 0; i < 32; i++) { S[i] = a * S[i] + kt[dq * 32 + i] * coef; o += qt[dq * 32 + i] * S[i]; }
    red2[dq * 128 + e] = o;
    __syncthreads();
    if (dq == 0) {
      o = red2[e] + red2[128 + e] + red2[256 + e] + red2[384 + e];
      OA[(size_t)tok * 1024 + h * 128 + e] = f2bf(o);
      osq[e] = o * o;
    }
    __syncthreads();
    if (w == 0) {
      float s2 = wave_sum(osq[lane] + osq[64 + lane]);
      if (lane < 8) SSQ[(size_t)tok * 64 + h * 8 + lane] = lane == 0 ? s2 : 0.f;
    }
  }
  float* so = p.out + O_SS + ((size_t)(s * 8 + h) * 128 + dq * 32) * 128 + e;
#pragma unroll
  for (int i = 0; i < 32; i++) so[(size_t)i * 128] = S[i];
}

template <int TM>
DI void phase4_tile(const P& p, char* smem, int m0, int nt) {
  const u16* XN = (const u16*)p.out;
  const u16* WT = (const u16*)(p.ws + WS_WIN);
  u16* Qn = (u16*)(p.ws + WS_BIG);
  u16* Kn = (u16*)(p.ws + WS_BIG + BIG_KN);
  u16* Vt = (u16*)(p.ws + WS_BIG + BIG_VT);
  const int lane = threadIdx.x & 63, w = __builtin_amdgcn_readfirstlane(threadIdx.x >> 6), wm = w >> 1, wn = w & 1;
  {
    const u16* wbase = WT + (size_t)(C_FQ + nt * 128) * 1024;
    auto brow = [&](int r) { return wbase + (size_t)r * 1024; };
    f32x4 acc[TM][4];
    if (nt < 16) {
      gemm_main<128, false, true, 4, decltype(brow), TM>(XN, m0, brow, smem, acc);
      const bool isq = nt < 8;
      const int hh = nt & 7, m = wn;
      const float* gain = isq ? p.qn_g : p.kn_g;
#pragma unroll
      for (int i = 0; i < TM; i++) {
        int tok = m0 + wm * (TM * 16) + i * 16 + (lane & 15);
        float ss = 0.f;
#pragma unroll
        for (int j = 0; j < 4; j++)
#pragma unroll
          for (int rr = 0; rr < 4; rr++) ss += acc[i][j][rr] * acc[i][j][rr];
        ss += __shfl_xor(ss, 16); ss += __shfl_xor(ss, 32);
        float rinv = rsqrtf(ss * (1.f / 64.f) + RMS_EPS);
#pragma unroll
        for (int j = 0; j < 4; j++) {
          int dd = j * 16 + 4 * (lane >> 4);
          float4 g4 = *(const float4*)(gain + dd);
          float o0 = acc[i][j][0] * rinv * g4.x, o1 = acc[i][j][1] * rinv * g4.y, o2 = acc[i][j][2] * rinv * g4.z, o3 = acc[i][j][3] * rinv * g4.w;
          int col = hh * 128 + m * 64 + dd;
          if (isq) {
            u32x2 ov = {pack2(o0 * QSCALE, o1 * QSCALE), pack2(o2 * QSCALE, o3 * QSCALE)};
            *(u32x2*)(Qn + (size_t)tok * 1024 + col) = ov;
          } else {
            u32x2 ov = {pack2(o0, o1), pack2(o2, o3)};
            *(u32x2*)(Kn + (size_t)tok * 1024 + col) = ov;
            float* kd = tok < TP ? p.out + O_KP + (size_t)tok * 1024 + col : p.out + O_KS + (size_t)(tok - TP) * 1024 + col;
            __builtin_nontemporal_store(f32x4{o0, o1, o2, o3}, (f32x4*)kd);
          }
        }
      }
    } else {
      gemm_main<128, false, false, 4, decltype(brow), TM>(XN, m0, brow, smem, acc);
      const int hh = nt - 16;
#pragma unroll
      for (int i = 0; i < TM; i++) {
        int tok = m0 + wm * (TM * 16) + i * 16 + 4 * (lane >> 4);
#pragma unroll
        for (int j = 0; j < 4; j++) {
          int dv = wn * 64 + j * 16 + (lane & 15);
          f32x4 a = acc[i][j];
          u32x2 ov = {pack2(a[0], a[1]), pack2(a[2], a[3])};
          if (tok < TP) {
            int b = tok >> 14, tt = tok & 16383;
            *(u32x2*)(Vt + ((size_t)(b * 8 + hh) * 128 + dv) * SEQ + (tt & ~15) + 4 * VPERM((tt >> 2) & 3)) = ov;
#pragma unroll
            for (int rr = 0; rr < 4; rr++) __builtin_nontemporal_store(a[rr], &p.out[O_VP + (size_t)(tok + rr) * 1024 + hh * 128 + dv]);
          } else {
            int s = (tok - TP) >> 4, tt = tok & 15;
            *(u32x2*)(Vt + (size_t)33554432 + ((size_t)(s * 8 + hh) * 128 + dv) * 16 + 4 * VPERM((tt >> 2) & 3)) = ov;
#pragma unroll
            for (int rr = 0; rr < 4; rr++) __builtin_nontemporal_store(a[rr], &p.out[O_VS + (size_t)(tok - TP + rr) * 1024 + hh * 128 + dv]);
          }
        }
      }
    }
  }
}
DI void phase4(const P& p, char* smem, int bid, int nb, int nt0, int ntw) {
  for (int t = bid; t < 128 * ntw; t += nb) phase4_tile<4>(p, smem, (t / ntw) * 256, nt0 + t % ntw);
  for (int t = bid; t < 4 * ntw; t += nb) phase4_tile<1>(p, smem, TP + (t / ntw) * 64, nt0 + t % ntw);
}

DI float calc_lam(const P& p, int lane) {
  float a = wave_sum(p.lq1[lane] * p.lk1[lane]);
  float b = wave_sum(p.lq2[lane] * p.lk2[lane]);
  return __expf(a) - __expf(b) + LAM_INIT;
}
DI float calc_m2(const P& p, int lane) {
  float gq = wave_max(fabsf(p.qn_g[lane])), gk = wave_max(fabsf(p.kn_g[lane]));
  return 8.f * gq * gk * LOG2E * 1.03f + 0.1f;
}

DI void attn_prompt(const P& p, char* smem, int bh, int qb, float lam, float M2) {
  const int tid = threadIdx.x, lane = tid & 63, w = __builtin_amdgcn_readfirstlane(tid >> 6);
  const int sub = w >> 1, map = w & 1, b = bh >> 3, h = bh & 7;
  const int l31 = lane & 31, hf = lane >> 5;
  const u16* Qn = (const u16*)(p.ws + WS_BIG);
  const u16* Kn = (const u16*)(p.ws + WS_BIG + BIG_KN);
  const u16* Vt = (const u16*)(p.ws + WS_BIG + BIG_VT);
  u16* OB = (u16*)(p.ws + WS_OB);
  const int tok0 = b * SEQ + qb * 128;
  const int ntile = 2 * qb + 2;
  const int my_nt = 2 * qb + 1 + (sub >> 1);
  constexpr int TILEB = 32768;
  bf16x8 qf[4];
#pragma unroll
  for (int kk = 0; kk < 4; kk++) qf[kk] = ldfrag(Qn + (size_t)(tok0 + 32 * sub + l31) * 1024 + h * 128 + map * 64 + kk * 16 + hf * 8);
  f32x16 ot[4];
#pragma unroll
  for (int dt = 0; dt < 4; dt++)
#pragma unroll
    for (int i = 0; i < 16; i++) ot[dt][i] = 0.f;
  f32x16 zinit;
#pragma unroll
  for (int i = 0; i < 16; i++) zinit[i] = 0.f;
  float lsum = 0.f;
  const u16* kbase = Kn + (size_t)(b * SEQ) * 1024 + h * 128;
  const u16* vbase = Vt + (size_t)(b * 8 + h) * 128 * SEQ;
  const u16* gsrc[4];
#pragma unroll
  for (int ii = 0; ii < 4; ii++) {
    int r = (w * 4 + ii) * 8 + (lane >> 3), pos = lane & 7, c = pos ^ ((r >> 1) & 7);
    if (w < 4) { int key = r & 63, m = r >> 6; gsrc[ii] = kbase + (size_t)key * 1024 + m * 64 + c * 8; }
    else { int dv = r - 128; gsrc[ii] = vbase + (size_t)dv * SEQ + c * 8; }
  }
  const size_t gstep = w < 4 ? (size_t)64 * 1024 : (size_t)64;
  auto glds = [&](int kt, int bufi) {
    char* dst = smem + bufi * TILEB + w * 4096;
#pragma unroll
    for (int ii = 0; ii < 4; ii++)
      __builtin_amdgcn_global_load_lds((const unsigned*)(gsrc[ii] + (size_t)kt * gstep), (unsigned*)(dst + ii * 1024), 16, 0, 0);
  };
  const int swz16 = ((l31 >> 1) & 7) << 4;
  const int krow = (map * 64 + l31) * 128, vrow = (128 + l31) * 128;
  __syncthreads();
  asm volatile("s_waitcnt vmcnt(0)" ::: "memory");
  glds(0, 0);
  glds(1, 1);
  for (int kt = 0; kt < ntile; kt++) {
    if (kt + 1 < ntile) asm volatile("s_waitcnt vmcnt(4)" ::: "memory");
    else asm volatile("s_waitcnt vmcnt(0)" ::: "memory");
    RAW_BARRIER();
    if (kt + 2 < ntile) glds(kt + 2, (kt + 2) % 3);
    if (kt < my_nt) {
      const char* buf = smem + (kt % 3) * TILEB;
      bf16x8 kf[2][4];
#pragma unroll
      for (int tk = 0; tk < 2; tk++)
#pragma unroll
        for (int kk = 0; kk < 4; kk++) kf[tk][kk] = *(const bf16x8*)(buf + krow + tk * 4096 + (((kk * 2 + hf) << 4) ^ swz16));
      __builtin_amdgcn_sched_barrier(0);
      f32x16 st[2];
#pragma unroll
      for (int kk = 0; kk < 4; kk++)
#pragma unroll
        for (int tk = 0; tk < 2; tk++) st[tk] = mfma32(kf[tk][kk], qf[kk], kk == 0 ? zinit : st[tk]);
      __builtin_amdgcn_sched_barrier(0);
      bf16x8 vf0[4], vf1[4];
#pragma unroll
      for (int c4 = 0; c4 < 4; c4++) vf0[c4] = *(const bf16x8*)(buf + vrow + 0 * 4096 + (((c4 * 2 + hf) << 4) ^ swz16));
      __builtin_amdgcn_sched_barrier(0);
      bf16x8 pf[4];
#pragma unroll
      for (int tk = 0; tk < 2; tk++) {
        float pe[16];
#pragma unroll
        for (int i = 0; i < 16; i++) { pe[i] = __builtin_amdgcn_exp2f(st[tk][i]); lsum += pe[i]; }
#pragma unroll
        for (int s2 = 0; s2 < 2; s2++) {
          u32x4 pk = {pack2(pe[8 * s2], pe[8 * s2 + 1]), pack2(pe[8 * s2 + 2], pe[8 * s2 + 3]), pack2(pe[8 * s2 + 4], pe[8 * s2 + 5]), pack2(pe[8 * s2 + 6], pe[8 * s2 + 7])};
          pf[tk * 2 + s2] = __builtin_bit_cast(bf16x8, pk);
        }
      }
      __builtin_amdgcn_sched_barrier(0);
#pragma unroll
      for (int c4 = 0; c4 < 4; c4++) vf1[c4] = *(const bf16x8*)(buf + vrow + 1 * 4096 + (((c4 * 2 + hf) << 4) ^ swz16));
      __builtin_amdgcn_sched_barrier(0);
#pragma unroll
      for (int c4 = 0; c4 < 4; c4++) ot[0] = mfma32(vf0[c4], pf[c4], ot[0]);
      __builtin_amdgcn_sched_barrier(0);
#pragma unroll
      for (int c4 = 0; c4 < 4; c4++) vf0[c4] = *(const bf16x8*)(buf + vrow + 2 * 4096 + (((c4 * 2 + hf) << 4) ^ swz16));
      __builtin_amdgcn_sched_barrier(0);
#pragma unroll
      for (int c4 = 0; c4 < 4; c4++) ot[1] = mfma32(vf1[c4], pf[c4], ot[1]);
      __builtin_amdgcn_sched_barrier(0);
#pragma unroll
      for (int c4 = 0; c4 < 4; c4++) vf1[c4] = *(const bf16x8*)(buf + vrow + 3 * 4096 + (((c4 * 2 + hf) << 4) ^ swz16));
      __builtin_amdgcn_sched_barrier(0);
#pragma unroll
      for (int c4 = 0; c4 < 4; c4++) ot[2] = mfma32(vf0[c4], pf[c4], ot[2]);
      __builtin_amdgcn_sched_barrier(0);
#pragma unroll
      for (int c4 = 0; c4 < 4; c4++) ot[3] = mfma32(vf1[c4], pf[c4], ot[3]);
      __builtin_amdgcn_sched_barrier(0);
    }
  }
  __syncthreads();
  lsum += __shfl_xor(lsum, 32);
  const float linv = 1.f / lsum;
  float* Xs = (float*)smem;
  if (map == 1) {
#pragma unroll
    for (int dt = 0; dt < 4; dt++)
#pragma unroll
      for (int i = 0; i < 16; i++) Xs[(sub * 64 + dt * 16 + i) * 64 + lane] = ot[dt][i] * linv;
  }
  __syncthreads();
  if (map == 0) {
    float ss = 0.f;
#pragma unroll
    for (int dt = 0; dt < 4; dt++)
#pragma unroll
      for (int i = 0; i < 16; i++) {
        float v = ot[dt][i] * linv - lam * Xs[(sub * 64 + dt * 16 + i) * 64 + lane];
        ot[dt][i] = v;
        ss += v * v;
      }
    ss += __shfl_xor(ss, 32);
    const float rinv = rsqrtf(ss * (1.f / 128.f) + RMS_EPS) * (1.f - LAM_INIT);
    u16* orow = OB + (size_t)(tok0 + 32 * sub + l31) * 1024 + h * 128;
#pragma unroll
    for (int dt = 0; dt < 4; dt++)
#pragma unroll
      for (int g = 0; g < 4; g++) {
        int dv = dt * 32 + 8 * g + 4 * hf;
        float4 g4 = *(const float4*)(p.diff_norm_g + dv);
        u32x2 ov = {pack2(ot[dt][4 * g] * rinv * g4.x, ot[dt][4 * g + 1] * rinv * g4.y), pack2(ot[dt][4 * g + 2] * rinv * g4.z, ot[dt][4 * g + 3] * rinv * g4.w)};
        *(u32x2*)(orow + dv) = ov;
      }
  }
  __syncthreads();
}

DI void attn_sample(const P& p, char* smem, int s, int h, float lam, float M2) {
  const int tid = threadIdx.x, lane = tid & 63, w = tid >> 6;
  const u16* Qn = (const u16*)(p.ws + WS_BIG);
  const u16* Kn = (const u16*)(p.ws + WS_BIG + BIG_KN);
  const u16* VtS = (const u16*)(p.ws + WS_BIG + BIG_VT) + (size_t)33554432;
  u16* OB = (u16*)(p.ws + WS_OB);
  float* qs = (float*)smem;
  float* Ps = qs + 2048;
  float* Os = Ps + 2048;
  float* Kt = Os + 2048;
  float* Vl = Kt + 64 * 132;
  __syncthreads();
  for (int i = tid; i < 2048; i += NT) {
    int m = i >> 10, q = (i >> 6) & 15, d = i & 63;
    qs[i] = bf2f(Qn[(size_t)(TP + s * 16 + q) * 1024 + h * 128 + m * 64 + d]);
  }
  const int key = tid & 63, grp = tid >> 6, map = grp & 1, q0 = 4 * (grp >> 1);
  const int dv = tid & 127, qg = tid >> 7;
  float acc[2][4], ls[2][4];
#pragma unroll
  for (int m = 0; m < 2; m++)
#pragma unroll
    for (int qq = 0; qq < 4; qq++) { acc[m][qq] = 0.f; ls[m][qq] = 0.f; }
  float4 rk0, rk1, rk2, rk3, rv0, rv1, rv2, rv3;
#define SGLOAD(kt_)                                                                                         \
  {                                                                                                         \
    size_t off = (((size_t)s * 1024 + (kt_) * 64 + (tid >> 5)) * 8 + h) * 128 + (tid & 31) * 4;             \
    rk0 = *(const float4*)(p.cache_k + off); rv0 = *(const float4*)(p.cache_v + off);                       \
    rk1 = *(const float4*)(p.cache_k + off + 16 * 1024); rv1 = *(const float4*)(p.cache_v + off + 16 * 1024); \
    rk2 = *(const float4*)(p.cache_k + off + 32 * 1024); rv2 = *(const float4*)(p.cache_v + off + 32 * 1024); \
    rk3 = *(const float4*)(p.cache_k + off + 48 * 1024); rv3 = *(const float4*)(p.cache_v + off + 48 * 1024); \
  }
  SGLOAD(0)
  for (int kt = 0; kt < 17; kt++) {
    const int nvalid = kt < 16 ? 64 : 16;
    __syncthreads();
    if (kt < 16) {
      {
        int kk = tid >> 5, c4 = tid & 31;
        *(float4*)(Kt + kk * 132 + c4 * 4) = rk0; *(float4*)(Vl + kk * 128 + c4 * 4) = rv0;
        *(float4*)(Kt + (kk + 16) * 132 + c4 * 4) = rk1; *(float4*)(Vl + (kk + 16) * 128 + c4 * 4) = rv1;
        *(float4*)(Kt + (kk + 32) * 132 + c4 * 4) = rk2; *(float4*)(Vl + (kk + 32) * 128 + c4 * 4) = rv2;
        *(float4*)(Kt + (kk + 48) * 132 + c4 * 4) = rk3; *(float4*)(Vl + (kk + 48) * 128 + c4 * 4) = rv3;
      }
      if (kt + 1 < 16) SGLOAD(kt + 1)
    } else {
      for (int i = tid; i < 16 * 128; i += NT) {
        int kk = i >> 7, c = i & 127;
        Kt[kk * 132 + c] = bf2f(Kn[(size_t)(TP + s * 16 + kk) * 1024 + h * 128 + c]);
        Vl[kk * 128 + c] = bf2f(VtS[((size_t)(s * 8 + h) * 128 + c) * 16 + 4 * VPERM((kk >> 2) & 3) + (kk & 3)]);
      }
    }
    __syncthreads();
    float d0 = 0.f, d1 = 0.f, d2 = 0.f, d3 = 0.f;
    {
      const float* qp = qs + (map * 16 + q0) * 64;
#pragma unroll
      for (int c = 0; c < 16; c++) {
        float4 kv = *(const float4*)(Kt + key * 132 + map * 64 + c * 4);
        float4 a0 = *(const float4*)(qp + c * 4), a1 = *(const float4*)(qp + 64 + c * 4), a2 = *(const float4*)(qp + 128 + c * 4), a3 = *(const float4*)(qp + 192 + c * 4);
        d0 += kv.x * a0.x + kv.y * a0.y + kv.z * a0.z + kv.w * a0.w;
        d1 += kv.x * a1.x + kv.y * a1.y + kv.z * a1.z + kv.w * a1.w;
        d2 += kv.x * a2.x + kv.y * a2.y + kv.z * a2.z + kv.w * a2.w;
        d3 += kv.x * a3.x + kv.y * a3.y + kv.z * a3.z + kv.w * a3.w;
      }
    }
    {
      const bool ok = key < nvalid;
      float* pp = Ps + (map * 16 + q0) * 64 + key;
      pp[0] = ok ? __builtin_amdgcn_exp2f(d0 - M2) : 0.f;
      pp[64] = ok ? __builtin_amdgcn_exp2f(d1 - M2) : 0.f;
      pp[128] = ok ? __builtin_amdgcn_exp2f(d2 - M2) : 0.f;
      pp[192] = ok ? __builtin_amdgcn_exp2f(d3 - M2) : 0.f;
    }
    __syncthreads();
    for (int k2 = 0; k2 < nvalid; k2++) {
      float v = Vl[k2 * 128 + dv];
#pragma unroll
      for (int m = 0; m < 2; m++)
#pragma unroll
        for (int qq = 0; qq < 4; qq++) {
          float pp = Ps[(m * 16 + 4 * qg + qq) * 64 + k2];
          acc[m][qq] += pp * v;
          ls[m][qq] += pp;
        }
    }
  }
#pragma unroll
  for (int qq = 0; qq < 4; qq++) Os[(4 * qg + qq) * 128 + dv] = acc[0][qq] / ls[0][qq] - lam * acc[1][qq] / ls[1][qq];
  __syncthreads();
  for (int i = 0; i < 2; i++) {
    int q = w * 2 + i;
    float a0 = Os[q * 128 + lane], a1 = Os[q * 128 + 64 + lane];
    float ss = wave_sum(a0 * a0 + a1 * a1);
    float rinv = rsqrtf(ss * (1.f / 128.f) + RMS_EPS) * (1.f - LAM_INIT);
    u16* orow = OB + (size_t)(TP + s * 16 + q) * 1024 + h * 128;
    orow[lane] = f2bf(a0 * rinv * p.diff_norm_g[lane]);
    orow[64 + lane] = f2bf(a1 * rinv * p.diff_norm_g[64 + lane]);
  }
  __syncthreads();
}

DI void phase5(const P& p, char* smem, int bid, int nb) {
  const int lane = threadIdx.x & 63;
  const float lam = calc_lam(p, lane);
  const float M2 = calc_m2(p, lane);
  const int nitems = 2048 + 128;
  for (int k = 0;; k++) {
    int x = (k & 1) ? (nb - 1 - bid) : bid;
    int id = k * nb + x;
    if (k * nb >= nitems) break;
    if (id >= nitems) continue;
    if (id < 2048) {
      int bh = (id & 7) + 8 * ((id >> 3) & 1), qb = 127 - (id >> 4);
      attn_prompt(p, smem, bh, qb, lam, M2);
    } else {
      int sid = id - 2048;
      attn_sample(p, smem, sid >> 3, sid & 7, lam, M2);
    }
  }
}

template <int TM>
DI void phase6_tile(const P& p, char* smem, int m0, int n0) {
  const u16* XN = (const u16*)p.out;
  const u16* WT = (const u16*)(p.ws + WS_WIN);
  u16* OA = (u16*)(p.ws + WS_OA);
  const u16* OB = (const u16*)(p.ws + WS_OB);
  const float* SSQ = (const float*)(p.ws + WS_SSQ);
  const int lane = threadIdx.x & 63, w = __builtin_amdgcn_readfirstlane(threadIdx.x >> 6), wm = w >> 1, wn = w & 1;
  {
    f32x4 acc[TM][6];
    auto brow = [&](int r) {
      int seg = r >> 6, c = r & 63;
      int col = (seg == 0 ? C_Z : (seg == 1 ? C_GA : C_GB)) + n0 + c;
      return WT + (size_t)col * 1024; };
    gemm_main<192, true, true, 6, decltype(brow), TM>(XN, m0, brow, smem, acc);
    const int head = n0 >> 7;
#pragma unroll
    for (int i = 0; i < TM; i++) {
      int tok = m0 + wm * (TM * 16) + i * 16 + (lane & 15);
      const float4* sp = (const float4*)(SSQ + (size_t)tok * 64 + head * 8);
      float4 s0 = sp[0], s1 = sp[1];
      float ssq = s0.x + s0.y + s0.z + s0.w + s1.x + s1.y + s1.z + s1.w;
      float rinv = rsqrtf(ssq * (1.f / 128.f) + RMS_EPS);
#pragma unroll
      for (int jj = 0; jj < 2; jj++) {
        int ch = n0 + wn * 32 + jj * 16 + 4 * (lane >> 4);
        u32x2 oa = *(const u32x2*)(OA + (size_t)tok * 1024 + ch);
        u32x2 ob = *(const u32x2*)(OB + (size_t)tok * 1024 + ch);
        float4 g4 = *(const float4*)(p.delta_norm_g + (ch & 127));
        float av[4] = {bflo(oa[0]), bfhi(oa[0]), bflo(oa[1]), bfhi(oa[1])};
        float bv[4] = {bflo(ob[0]), bfhi(ob[0]), bflo(ob[1]), bfhi(ob[1])};
        float gv[4] = {g4.x, g4.y, g4.z, g4.w};
        float o[4];
#pragma unroll
        for (int rr = 0; rr < 4; rr++) {
          float z = acc[i][jj][rr], ga = acc[i][2 + jj][rr], gb = acc[i][4 + jj][rr];
          float oan = av[rr] * rinv * gv[rr] * (z / (1.f + __expf(-z)));
          o[rr] = sigmoidf_(ga) * oan + sigmoidf_(gb) * bv[rr];
        }
        u32x2 ov = {pack2(o[0], o[1]), pack2(o[2], o[3])};
        *(u32x2*)(OA + (size_t)tok * 1024 + ch) = ov;
      }
    }
  }
}
DI void phase6(const P& p, char* smem, int bid, int nb) {
  for (int t = bid; t < 128 * 16; t += nb) phase6_tile<4>(p, smem, (t / 16) * 256, (t % 16) * 64);
  for (int t = bid; t < 4 * 16; t += nb) phase6_tile<1>(p, smem, TP + (t / 16) * 64, (t % 16) * 64);
}

template <int TM>
DI void phase7_tile(const P& p, char* smem, int m0, int n0) {
  const u16* MG = (const u16*)(p.ws + WS_OA);
  const u16* WT = (const u16*)(p.ws + WS_WOUT);
  const int lane = threadIdx.x & 63, w = __builtin_amdgcn_readfirstlane(threadIdx.x >> 6), wm = w >> 1, wn = w & 1;
  f32x4 acc[TM][4];
  auto brow = [&](int r) { return WT + (size_t)(n0 + r) * 1024; };
  gemm_main<128, false, true, 4, decltype(brow), TM>(MG, m0, brow, smem, acc);
#pragma unroll
  for (int i = 0; i < TM; i++) {
    int tok = m0 + wm * (TM * 16) + i * 16 + (lane & 15);
    const float* xr = tok < TP ? p.x_prompt + (size_t)tok * D : p.x_sample + (size_t)(tok - TP) * D;
#pragma unroll
    for (int j = 0; j < 4; j++) {
      int n = n0 + wn * 64 + j * 16 + 4 * (lane >> 4);
      float4 xv = *(const float4*)(xr + n);
      f32x4 a = acc[i][j];
      *(float4*)(p.out + (size_t)tok * 1024 + n) = make_float4(xv.x + a[0], xv.y + a[1], xv.z + a[2], xv.w + a[3]);
    }
  }
}
DI void phase7(const P& p, char* smem, int bid, int nb) {
  for (int t = bid; t < 128 * 8; t += nb) phase7_tile<4>(p, smem, (t / 8) * 256, (t % 8) * 128);
  for (int t = bid; t < 4 * 8; t += nb) phase7_tile<1>(p, smem, TP + (t / 8) * 64, (t % 8) * 128);
}

DI void conv_fp8_rows(const float* __restrict__ src, u32* __restrict__ dst8, float* __restrict__ inv_scale, int gw, int gws, int lane) {
  for (int row = gw; row < 16384; row += gws) {
    const float4* rp = (const float4*)(src + (size_t)row * 1024 + lane * 16);
    float4 a0 = rp[0], a1 = rp[1], a2 = rp[2], a3 = rp[3];
    float m = fmaxf(fmaxf(fmaxf(fabsf(a0.x), fabsf(a0.y)), fmaxf(fabsf(a0.z), fabsf(a0.w))), fmaxf(fmaxf(fabsf(a1.x), fabsf(a1.y)), fmaxf(fabsf(a1.z), fabsf(a1.w))));
    m = fmaxf(m, fmaxf(fmaxf(fmaxf(fabsf(a2.x), fabsf(a2.y)), fmaxf(fabsf(a2.z), fabsf(a2.w))), fmaxf(fmaxf(fabsf(a3.x), fabsf(a3.y)), fmaxf(fabsf(a3.z), fabsf(a3.w)))));
    m = wave_max(m);
    float sc = m > 0.f ? exp2f(floorf(log2f(448.f / m))) : 1.f;
    u32x4 o;
    int t;
    t = __builtin_amdgcn_cvt_pk_fp8_f32(a0.x * sc, a0.y * sc, 0, false); t = __builtin_amdgcn_cvt_pk_fp8_f32(a0.z * sc, a0.w * sc, t, true); o[0] = (u32)t;
    t = __builtin_amdgcn_cvt_pk_fp8_f32(a1.x * sc, a1.y * sc, 0, false); t = __builtin_amdgcn_cvt_pk_fp8_f32(a1.z * sc, a1.w * sc, t, true); o[1] = (u32)t;
    t = __builtin_amdgcn_cvt_pk_fp8_f32(a2.x * sc, a2.y * sc, 0, false); t = __builtin_amdgcn_cvt_pk_fp8_f32(a2.z * sc, a2.w * sc, t, true); o[2] = (u32)t;
    t = __builtin_amdgcn_cvt_pk_fp8_f32(a3.x * sc, a3.y * sc, 0, false); t = __builtin_amdgcn_cvt_pk_fp8_f32(a3.z * sc, a3.w * sc, t, true); o[3] = (u32)t;
    *(u32x4*)(dst8 + (size_t)row * 256 + lane * 4) = o;
    if (lane == 0) inv_scale[row] = 1.f / sc;
  }
}

DI void phase8(const P& p, int bid, int nb) {
  const int lane = threadIdx.x & 63, w = threadIdx.x >> 6;
  u16* HN = (u16*)(p.ws + WS_OB);
#pragma unroll 2
  for (int row = bid * 8 + w; row < TT; row += nb * 8) {
    const float* hr = p.out + (size_t)row * 1024;
    float4 v[4];
    float ss = 0.f;
#pragma unroll
    for (int i = 0; i < 4; i++) { v[i] = *(const float4*)(hr + i * 256 + lane * 4); ss += v[i].x * v[i].x + v[i].y * v[i].y + v[i].z * v[i].z + v[i].w * v[i].w; }
    ss = wave_sum(ss);
    float rinv = rsqrtf(ss * (1.f / 1024.f) + RMS_EPS);
#pragma unroll
    for (int i = 0; i < 4; i++) {
      float4 g4 = *(const float4*)(p.norm_ffn_g + i * 256 + lane * 4);
      u32x2 o = {pack2(v[i].x * rinv * g4.x, v[i].y * rinv * g4.y), pack2(v[i].z * rinv * g4.z, v[i].w * rinv * g4.w)};
      *(u32x2*)(HN + (size_t)row * 1024 + i * 256 + lane * 4) = o;
    }
  }
}

DI u32 mono_key(float s, int n) {
  u32 b = __float_as_uint(s);
  u32 m = b ^ ((b >> 31) ? 0xFFFFFFFFu : 0x80000000u);
  return (m & 0xFFFFFF80u) | (u32)n;
}
DI float mono_val(u32 k) {
  u32 m = k & 0xFFFFFF80u;
  u32 b = (m & 0x80000000u) ? (m ^ 0x80000000u) : ~m;
  return __uint_as_float(b);
}
DI void top_insert(u32 (&t)[16], u32 x) {
#pragma unroll
  for (int i = 15; i >= 0; i--) { u32 hi = max(t[i], x), lo = min(t[i], x); t[i] = hi; x = lo; }
}
DI void top_insert_desc(u32 (&t)[16], u32 x) {
#pragma unroll
  for (int i = 0; i < 16; i++) { u32 hi = max(t[i], x), lo = min(t[i], x); t[i] = hi; x = lo; }
}

DI void ce_desc(u32& a, u32& b) { u32 hi = max(a, b), lo = min(a, b); a = hi; b = lo; }
DI void bitonic_sort16_desc(u32 (&a)[16]) {
#pragma unroll
  for (int k = 2; k <= 16; k <<= 1)
#pragma unroll
    for (int j = k >> 1; j > 0; j >>= 1)
#pragma unroll
      for (int i = 0; i < 16; i++) {
        const int l = i ^ j;
        if (l > i) { if ((i & k) == 0) ce_desc(a[i], a[l]); else ce_desc(a[l], a[i]); }
      }
}
DI void merge_top16_desc(u32 (&t)[16], const u32 (&b)[16]) {
#pragma unroll
  for (int i = 0; i < 16; i++) t[i] = max(t[i], b[15 - i]);
#pragma unroll
  for (int j = 8; j > 0; j >>= 1)
#pragma unroll
    for (int i = 0; i < 16; i++) { const int l = i ^ j; if (l > i) ce_desc(t[i], t[l]); }
}

template <int TM>
DI void phase9_tile(const P& p, char* smem, int m0, int nt) {
  const u16* HN = (const u16*)(p.ws + WS_OB);
  const u16* WT = (const u16*)(p.ws + WS_WQ);
  const u16* SK = (const u16*)(p.ws + WS_SK);
  u32* SEL = (u32*)(p.ws + WS_SEL);
  const int tid = threadIdx.x, lane = tid & 63, w = __builtin_amdgcn_readfirstlane(tid >> 6), wm = w >> 1, wn = w & 1;
  u16* Qs = (u16*)smem;
  u16* Ks = Qs + 256 * 136;
  u32* Sc = (u32*)smem;
  const int n0 = nt * 128;
  {
    f32x4 acc[TM][4];
    auto brow = [&](int r) { return WT + (size_t)(n0 + r) * 1024; };
    gemm_main<128, false, true, 4, decltype(brow), TM>(HN, m0, brow, smem, acc);
#pragma unroll
    for (int i = 0; i < TM; i++)
#pragma unroll
      for (int j = 0; j < 4; j++) {
        int tl = wm * (TM * 16) + i * 16 + (lane & 15), d = wn * 64 + j * 16 + 4 * (lane >> 4);
        u32x2 ov = {pack2(acc[i][j][0], acc[i][j][1]), pack2(acc[i][j][2], acc[i][j][3])};
        *(u32x2*)(Qs + tl * 136 + d) = ov;
      }
#pragma unroll
    for (int i = 0; i < 4; i++) {
      int c = tid + 512 * i, n = c >> 4, d8 = c & 15;
      *(u32x4*)(Ks + n * 136 + d8 * 8) = *(const u32x4*)(SK + (size_t)(nt * 128 + n) * 128 + d8 * 8);
    }
    __syncthreads();
#pragma unroll
    for (int i = 0; i < TM; i++)
#pragma unroll
      for (int j = 0; j < 4; j++) acc[i][j] = f32x4{0.f, 0.f, 0.f, 0.f};
#pragma unroll
    for (int kk = 0; kk < 4; kk++) {
      bf16x8 qfr[TM], kfr[4];
#pragma unroll
      for (int i = 0; i < TM; i++) qfr[i] = ldfrag(Qs + (wm * (TM * 16) + i * 16 + (lane & 15)) * 136 + kk * 32 + (lane >> 4) * 8);
#pragma unroll
      for (int j = 0; j < 4; j++) kfr[j] = ldfrag(Ks + (wn * 64 + j * 16 + (lane & 15)) * 136 + kk * 32 + (lane >> 4) * 8);
#pragma unroll
      for (int i = 0; i < TM; i++)
#pragma unroll
        for (int j = 0; j < 4; j++) acc[i][j] = mfma16(kfr[j], qfr[i], acc[i][j]);
    }
    __syncthreads();
#pragma unroll
    for (int i = 0; i < TM; i++)
#pragma unroll
      for (int j = 0; j < 4; j++)
#pragma unroll
        for (int rr = 0; rr < 4; rr++) {
          int tl = wm * (TM * 16) + i * 16 + (lane & 15), n = wn * 64 + j * 16 + 4 * (lane >> 4) + rr;
          Sc[tl * 129 + n] = mono_key(acc[i][j][rr], n);
        }
    __syncthreads();
    {
      const int row = tid & 255, half = tid >> 8;
      const bool rowok = row < TM * 64;
      u32 tk[16];
      const u32* src = Sc + (rowok ? row : 0) * 129 + half * 64;
#pragma unroll
      for (int i = 0; i < 16; i++) tk[i] = src[i];
      bitonic_sort16_desc(tk);
#pragma nounroll
      for (int blk = 1; blk < 4; blk++) {
        u32 bk[16];
#pragma unroll
        for (int i = 0; i < 16; i++) bk[i] = src[blk * 16 + i];
        bitonic_sort16_desc(bk);
        merge_top16_desc(tk, bk);
      }
      if (half == 1 && rowok) {
#pragma unroll
        for (int i = 0; i < 16; i++) Sc[row * 129 + 64 + i] = tk[i];
      }
      __syncthreads();
      if (half == 0 && rowok) {
        u32 bk[16];
#pragma unroll
        for (int i = 0; i < 16; i++) bk[i] = Sc[row * 129 + 64 + i];
        merge_top16_desc(tk, bk);
        u32* dst = SEL + ((size_t)(m0 + row) * 16 + nt) * 16;
#pragma unroll
        for (int i = 0; i < 4; i++) { u32x4 o = {tk[4 * i], tk[4 * i + 1], tk[4 * i + 2], tk[4 * i + 3]}; *(u32x4*)(dst + 4 * i) = o; }
      }
    }
    __syncthreads();
  }
}
DI void phase9(const P& p, char* smem, int bid, int nb) {
  for (int t = bid; t < 128 * 16; t += nb) phase9_tile<4>(p, smem, (t / 16) * 256, t % 16);
  for (int t = bid; t < 4 * 16; t += nb) phase9_tile<1>(p, smem, TP + (t / 16) * 64, t % 16);
}

__device__ const unsigned char PAIR_I[64] = {0,0,0,0,0,0,0,0,0,0,0,0,0,0,0,0, 1,1,1,1,1,1,1,1, 2,2,2,2,2, 3,3,3,3, 4,4,4, 5,5, 6,6, 7,7, 8,9,10,11,12,13,14,15, 0,0,0,0,0,0,0,0,0,0,0,0,0,0};
__device__ const unsigned char PAIR_J[64] = {0,1,2,3,4,5,6,7,8,9,10,11,12,13,14,15, 0,1,2,3,4,5,6,7, 0,1,2,3,4, 0,1,2,3, 0,1,2, 0,1, 0,1, 0,1, 0,0,0,0,0,0,0,0, 0,0,0,0,0,0,0,0,0,0,0,0,0,0};

struct PeerGrp { u32x4 ua[8], va[8]; float usl, vsl; };
DI f32x2 fp8lo(u32 w) { return __builtin_amdgcn_cvt_pk_f32_fp8((int)w, false); }
DI f32x2 fp8hi(u32 w) { return __builtin_amdgcn_cvt_pk_f32_fp8((int)w, true); }

template <bool DRY>
DI void phase10(const P& p, char* smem, int bid, int nb) {
  const int tid = threadIdx.x, lane = tid & 63, w = tid >> 6;
  const u16* HN = (const u16*)(p.ws + WS_OB);
  const u32* U8 = (const u32*)(p.ws + WS_U);
  const u32* V8 = (const u32*)(p.ws + WS_U + 16777216);
  const float* USC = (const float*)(p.ws + WS_V);
  const float* VSC = (const float*)(p.ws + WS_V + 65536);
  const u32* SEL = (const u32*)(p.ws + WS_SEL);
  int* le = (int*)smem + w * 512;
  float* lg = (float*)(le + 128);
  u32* selbuf = (u32*)(le + 256);
  const int pi = PAIR_I[lane], pj = PAIR_J[lane];
  const bool h5 = (lane & 32) != 0, h4 = (lane & 16) != 0;
  const bool h3 = (lane & 8) != 0;
  const int ql = (h5 ? 4 : 0) + (h4 ? 2 : 0) + (h3 ? 1 : 0);
  u32 nw[8];
  {
    const int tok0 = bid * 8 + w;
#pragma unroll
    for (int h = 0; h < 8; h++) nw[h] = (tok0 < TP) ? SEL[((size_t)tok0 * 16 + h * 2) * 16 + (lane & 31)] : 0u;
  }
  for (int tok = bid * 8 + w; tok < TP; tok += nb * 8) {
#pragma unroll
    for (int h = 0; h < 8; h++) selbuf[h * 32 + (lane & 31)] = nw[h];
    {
      const int tokn = tok + nb * 8;
#pragma unroll
      for (int h = 0; h < 8; h++) nw[h] = (tokn < TP) ? SEL[((size_t)tokn * 16 + h * 2) * 16 + (lane & 31)] : 0u;
    }
    for (int h = 0; h < 8; h++) {
      u32 word = lane < 32 ? selbuf[h * 32 + lane] : 0u;
      float val = mono_val(word);
      int idx = word & 127;
      float sa = __shfl(val, pi), sb = __shfl(val, 16 + pj);
      int ia = __shfl(idx, pi), ib = __shfl(idx, 16 + pj);
      float sum = lane < 50 ? sa + sb : -3.0e38f;
      int cnt = 0;
#pragma unroll
      for (int m = 0; m < 50; m++) {
        float sm = __int_as_float(__builtin_amdgcn_readlane(__float_as_int(sum), m));
        cnt += (sm > sum || (sm == sum && m < lane)) ? 1 : 0;
      }
      bool sel = lane < 50 && cnt < 16;
      float mx = wave_max(sum);
      float e = sel ? __expf(sum - mx) : 0.f;
      float tot = wave_sum(e);
      if (sel) { le[h * 16 + cnt] = ia * 128 + ib; lg[h * 16 + cnt] = e / tot; }
    }
    f32x2 hv2[8];
    {
      const u32x4 hw0 = *(const u32x4*)(HN + (size_t)tok * 1024 + lane * 16), hw1 = *(const u32x4*)(HN + (size_t)tok * 1024 + lane * 16 + 8);
#pragma unroll
      for (int c = 0; c < 4; c++) { hv2[c] = f32x2{bflo(hw0[c]), bfhi(hw0[c])}; hv2[4 + c] = f32x2{bflo(hw1[c]), bfhi(hw1[c])}; }
    }
    f32x2 acc2[8];
#pragma unroll
    for (int c = 0; c < 8; c++) acc2[c] = f32x2{0.f, 0.f};
    __builtin_amdgcn_wave_barrier();
    auto gload = [&](PeerGrp& g, int k0) {
#pragma unroll
      for (int q = 0; q < 8; q++) {
        int eid = le[k0 + q];
        g.ua[q] = *(const u32x4*)(U8 + (size_t)eid * 256 + lane * 4);
        g.va[q] = *(const u32x4*)(V8 + (size_t)eid * 256 + lane * 4);
      }
      const int eql = le[k0 + ql];
      g.usl = USC[eql];
      g.vsl = VSC[eql];
    };
    auto compute = [&](const PeerGrp& g, int k0) {
      float d[8];
#pragma unroll
      for (int q = 0; q < 8; q++) {
        f32x2 x = {0.f, 0.f};
#pragma unroll
        for (int c = 0; c < 4; c++) { x += fp8lo(g.ua[q][c]) * hv2[2 * c]; x += fp8hi(g.ua[q][c]) * hv2[2 * c + 1]; }
        d[q] = x[0] + x[1];
      }
      float r4[4], r2[2];
#pragma unroll
      for (int i = 0; i < 4; i++) r4[i] = (h5 ? d[4 + i] : d[i]) + __shfl_xor(h5 ? d[i] : d[4 + i], 32);
#pragma unroll
      for (int i = 0; i < 2; i++) r2[i] = (h4 ? r4[2 + i] : r4[i]) + __shfl_xor(h4 ? r4[i] : r4[2 + i], 16);
      float r = (h3 ? r2[1] : r2[0]) + __shfl_xor(h3 ? r2[0] : r2[1], 8);
      r += __shfl_xor(r, 4); r += __shfl_xor(r, 2); r += __shfl_xor(r, 1);
      r *= g.usl;
      float cf = lg[k0 + ql] * 0.5f * r * (1.f + erff(r * 0.7071067811865476f)) * g.vsl;
#pragma unroll
      for (int q = 0; q < 8; q++) {
        float cq = __int_as_float(__builtin_amdgcn_readlane(__float_as_int(cf), ((q >> 2) << 5) | (((q >> 1) & 1) << 4) | ((q & 1) << 3)));
        f32x2 cv = {cq, cq};
#pragma unroll
        for (int c = 0; c < 4; c++) { acc2[2 * c] += cv * fp8lo(g.va[q][c]); acc2[2 * c + 1] += cv * fp8hi(g.va[q][c]); }
      }
    };
    PeerGrp ga, gb;
    gload(ga, 0);
    for (int k0 = 0; k0 < 128; k0 += 16) {
      gload(gb, k0 + 8);
      compute(ga, k0);
      if (k0 + 16 < 128) gload(ga, k0 + 16);
      compute(gb, k0 + 8);
    }
    __builtin_amdgcn_wave_barrier();
    float* yr = p.out + (size_t)tok * 1024 + lane * 16;
    float4 y0 = *(float4*)(yr), y1 = *(float4*)(yr + 4), y2 = *(float4*)(yr + 8), y3 = *(float4*)(yr + 12);
    y0.x += acc2[0][0]; y0.y += acc2[0][1]; y0.z += acc2[1][0]; y0.w += acc2[1][1];
    y1.x += acc2[2][0]; y1.y += acc2[2][1]; y1.z += acc2[3][0]; y1.w += acc2[3][1];
    y2.x += acc2[4][0]; y2.y += acc2[4][1]; y2.z += acc2[5][0]; y2.w += acc2[5][1];
    y3.x += acc2[6][0]; y3.y += acc2[6][1]; y3.z += acc2[7][0]; y3.w += acc2[7][1];
    if (!DRY || y0.x + y1.y + y2.z == 1.2345e30f) {
      *(float4*)(yr) = y0; *(float4*)(yr + 4) = y1; *(float4*)(yr + 8) = y2; *(float4*)(yr + 12) = y3;
    }
  }

  float* red = (float*)(smem + 16384);
  for (int tok = TP + bid; tok < TT; tok += nb) {
    {
      const int h = 0;
      u32 word = lane < 32 ? SEL[((size_t)tok * 16 + w * 2) * 16 + lane] : 0u;
      float val = mono_val(word);
      int idx = word & 127;
      float sa = __shfl(val, pi), sb = __shfl(val, 16 + pj);
      int ia = __shfl(idx, pi), ib = __shfl(idx, 16 + pj);
      float sum = lane < 50 ? sa + sb : -3.0e38f;
      int cnt = 0;
#pragma unroll
      for (int m = 0; m < 50; m++) {
        float sm = __int_as_float(__builtin_amdgcn_readlane(__float_as_int(sum), m));
        cnt += (sm > sum || (sm == sum && m < lane)) ? 1 : 0;
      }
      bool sel = lane < 50 && cnt < 16;
      float mx = wave_max(sum);
      float e = sel ? __expf(sum - mx) : 0.f;
      float tot = wave_sum(e);
      if (sel) { le[h * 16 + cnt] = ia * 128 + ib; lg[h * 16 + cnt] = e / tot; }
    }
    f32x2 hv2[8];
    {
      const u32x4 hw0 = *(const u32x4*)(HN + (size_t)tok * 1024 + lane * 16), hw1 = *(const u32x4*)(HN + (size_t)tok * 1024 + lane * 16 + 8);
#pragma unroll
      for (int c = 0; c < 4; c++) { hv2[c] = f32x2{bflo(hw0[c]), bfhi(hw0[c])}; hv2[4 + c] = f32x2{bflo(hw1[c]), bfhi(hw1[c])}; }
    }
    f32x2 acc2[8];
#pragma unroll
    for (int c = 0; c < 8; c++) acc2[c] = f32x2{0.f, 0.f};
    __builtin_amdgcn_wave_barrier();
    auto gload = [&](PeerGrp& g, int k0) {
#pragma unroll
      for (int q = 0; q < 8; q++) {
        int eid = le[k0 + q];
        g.ua[q] = *(const u32x4*)(U8 + (size_t)eid * 256 + lane * 4);
        g.va[q] = *(const u32x4*)(V8 + (size_t)eid * 256 + lane * 4);
      }
      const int eql = le[k0 + ql];
      g.usl = USC[eql];
      g.vsl = VSC[eql];
    };
    auto compute = [&](const PeerGrp& g, int k0) {
      float d[8];
#pragma unroll
      for (int q = 0; q < 8; q++) {
        f32x2 x = {0.f, 0.f};
#pragma unroll
        for (int c = 0; c < 4; c++) { x += fp8lo(g.ua[q][c]) * hv2[2 * c]; x += fp8hi(g.ua[q][c]) * hv2[2 * c + 1]; }
        d[q] = x[0] + x[1];
      }
      float r4[4], r2[2];
#pragma unroll
      for (int i = 0; i < 4; i++) r4[i] = (h5 ? d[4 + i] : d[i]) + __shfl_xor(h5 ? d[i] : d[4 + i], 32);
#pragma unroll
      for (int i = 0; i < 2; i++) r2[i] = (h4 ? r4[2 + i] : r4[i]) + __shfl_xor(h4 ? r4[i] : r4[2 + i], 16);
      float r = (h3 ? r2[1] : r2[0]) + __shfl_xor(h3 ? r2[0] : r2[1], 8);
      r += __shfl_xor(r, 4); r += __shfl_xor(r, 2); r += __shfl_xor(r, 1);
      r *= g.usl;
      float cf = lg[k0 + ql] * 0.5f * r * (1.f + erff(r * 0.7071067811865476f)) * g.vsl;
#pragma unroll
      for (int q = 0; q < 8; q++) {
        float cq = __int_as_float(__builtin_amdgcn_readlane(__float_as_int(cf), ((q >> 2) << 5) | (((q >> 1) & 1) << 4) | ((q & 1) << 3)));
        f32x2 cv = {cq, cq};
#pragma unroll
        for (int c = 0; c < 4; c++) { acc2[2 * c] += cv * fp8lo(g.va[q][c]); acc2[2 * c + 1] += cv * fp8hi(g.va[q][c]); }
      }
    };
    PeerGrp ga, gb;
    gload(ga, 0);
    gload(gb, 8);
    compute(ga, 0);
    compute(gb, 8);
#pragma unroll
    for (int c = 0; c < 8; c++) *(f32x2*)(red + w * 1024 + lane * 16 + c * 2) = acc2[c];
    __syncthreads();
    {
      const int c0 = tid * 2;
      float a0 = 0.f, a1 = 0.f;
#pragma unroll
      for (int q = 0; q < 8; q++) { a0 += red[q * 1024 + c0]; a1 += red[q * 1024 + c0 + 1]; }
      float* yr = p.out + (size_t)tok * 1024 + c0;
      float2 yv = *(float2*)yr;
      yv.x += a0; yv.y += a1;
      if (!DRY || yv.x == 1.2345e30f) *(float2*)yr = yv;
    }
    __syncthreads();
  }
}

DI void phase3(const P& p, char* smem, int bid, int nb) {
  for (int id = bid; id < 256; id += nb) { if (id < 128) phase3_prompt(p, smem, id); else phase3_sample(p, smem, id - 128); }
  const int hb = nb > 128 ? bid - 128 : bid, nh = nb > 128 ? nb - 128 : nb;
  if (hb >= 0) {
    const int lane_ = threadIdx.x & 63, w_ = threadIdx.x >> 6;
    conv_fp8_rows(p.peer_u, (u32*)(p.ws + WS_U), (float*)(p.ws + WS_V), hb * 8 + w_, nh * 8, lane_);
    conv_fp8_rows(p.peer_v, (u32*)(p.ws + WS_U + 16777216), (float*)(p.ws + WS_V + 65536), hb * 8 + w_, nh * 8, lane_);
    for (int u = hb * 8 + w_; u < 16 * 8; u += nh * 8) transpose_unit(p.w_out, 1024, (u16*)(p.ws + WS_WOUT), u, lane_);
    for (int u = hb * 8 + w_; u < 32 * 8; u += nh * 8) transpose_unit(p.peer_wq, 2048, (u16*)(p.ws + WS_WQ), u, lane_);
    conv_tab(p.peer_sk, (u16*)(p.ws + WS_SK), (size_t)262144 / 4, (size_t)hb * NT + threadIdx.x, (size_t)nh * NT);
    phase4(p, smem, hb, nh, 0, 8);
  }
}

constexpr int NPHASE = 11;
#ifdef ONLY_PH
#define PHON(n) ((n) == ONLY_PH)
#else
#define PHON(n) true
#endif
__global__ void __launch_bounds__(NT) mega(P p, int lo, int hi) {
  extern __shared__ __attribute__((aligned(16))) char smem[];
  const int bid = blockIdx.x, nb = gridDim.x;
#ifndef DUP_PH
#define DUP_PH -1
#endif
#define RUNPH(n, body)                                   \
  if (DUP_PH == (n) && DUP_PH == 10) { phase10<true>(p, smem, bid, nb); __syncthreads(); } \
  if (PHON(n) && lo <= (n) && (n) < hi) { for (int rep = 0; rep < ((DUP_PH == (n) && DUP_PH != 10) ? hi - 9 : 1); rep++) { body; __syncthreads(); } }         \
  if (lo <= (n) && (n) + 1 < hi) cg::this_grid().sync();
  RUNPH(0, phase0(p, smem, bid, nb))
  RUNPH(1, phase1(p, smem, bid, nb))
  RUNPH(2, phase2(p, smem, bid, nb))
  RUNPH(3, phase3(p, smem, bid, nb))
  RUNPH(4, phase4(p, smem, bid, nb, 8, 16))
  RUNPH(5, phase5(p, smem, bid, nb))
  RUNPH(6, phase6(p, smem, bid, nb))
  RUNPH(7, phase7(p, smem, bid, nb))
  RUNPH(8, phase8(p, bid, nb))
  RUNPH(9, phase9(p, smem, bid, nb))
  RUNPH(10, phase10<false>(p, smem, bid, nb))
}

extern "C" void kernel_launch(void* const* d_in, const int* in_sizes, int n_in, void* d_out, int out_size, void* d_ws,
                              size_t ws_size, hipStream_t stream) {
  static int grid = 0;
  if (grid == 0) {
    int dev = 0, cus = 0, per_cu = 0;
    hipGetDevice(&dev);
    hipDeviceGetAttribute(&cus, hipDeviceAttributeMultiprocessorCount, dev);
    hipFuncSetAttribute((const void*)mega, hipFuncAttributeMaxDynamicSharedMemorySize, LDS_BYTES);
    hipOccupancyMaxActiveBlocksPerMultiprocessor(&per_cu, (const void*)mega, NT, LDS_BYTES);
    if (per_cu < 1) per_cu = 1;
    grid = cus * per_cu;
    if (ws_size < WS_END) { fprintf(stderr, "workspace too small: %zu < %zu\n", ws_size, (size_t)WS_END); }
  }
  P p{};
  const float** pp = (const float**)&p;
  for (int i = 0; i < 25; i++) pp[i] = (const float*)d_in[i];
  p.out = (float*)d_out;
  p.ws = (char*)d_ws;
#ifdef ONE_LAUNCH
  int lo = 0, hi = NPHASE;
  void* args[] = {&p, &lo, &hi};
  hipError_t e = hipLaunchCooperativeKernel((const void*)mega, dim3(grid), dim3(NT), args, LDS_BYTES, stream);
  if (e != hipSuccess) fprintf(stderr, "cooperative launch failed: %s (grid %d)\n", hipGetErrorString(e), grid);
#else
  for (int ph = 0; ph < NPHASE; ph++) hipLaunchKernelGGL(mega, dim3(grid), dim3(NT), LDS_BYTES, stream, p, ph, ph + 1);
#endif
}
```
